# Optimizing an MI355X kernel written in HIP

```python
import jax, jax.numpy as jnp
from jax import lax
import numpy as np

D_MODEL = 1024
BATCH = 16
SEQ = 256
DEPTH = 4
DEC_BATCH = 4
DEC_SEQ = 2048
PAST_LEN = 512

GRID_W = 64
N_MIXERS = 2
N_CONV_LAYERS = (DEPTH + 1) // 2
N_NA_LAYERS = DEPTH // 2
CONV_WIDTH = D_MODEL
CONV_K = 31
N_HEADS = 16
HEAD_DIM = D_MODEL // N_HEADS
NA_WIDTH = N_HEADS * HEAD_DIM
NA_ROW_WIN = 8
NA_COL_WIN = 16
Q_BLOCK = 128
EPS = 1e-6
NEG_INF = -1e30

kernel_name = 'hybrid_conv_natten_prefix_dit_step'


def rms_norm(x, g):
    x32 = x.astype(jnp.float32)
    y = x32 * lax.rsqrt(jnp.mean(x32 * x32, axis=-1, keepdims=True) + EPS)
    return y.astype(x.dtype) * g


def layer_norm(x, g, b):
    x32 = x.astype(jnp.float32)
    mu = jnp.mean(x32, axis=-1, keepdims=True)
    var = jnp.mean(jnp.square(x32 - mu), axis=-1, keepdims=True)
    return ((x32 - mu) * lax.rsqrt(var + EPS)).astype(x.dtype) * g + b


def ada_params(cvec, w, b):
    m = jax.nn.silu(cvec) @ w + b
    return jnp.split(m, 3, axis=-1)


def modulate(x, g, shift, scale):
    return rms_norm(x, g) * (1 + scale[:, None]) + shift[:, None]


def conv_branch(h, w_in, dw_w, dw_b, ln_g, ln_b, w_out):
    a, b, z = jnp.split(h @ w_in, 3, axis=-1)
    u = a * jax.nn.sigmoid(b)
    u = lax.conv_general_dilated(
        u, dw_w[:, None, :], window_strides=(1,),
        padding=[(CONV_K // 2, CONV_K // 2)],
        dimension_numbers=('NWC', 'WIO', 'NWC'),
        feature_group_count=CONV_WIDTH) + dw_b
    u = layer_norm(u, ln_g, ln_b)
    u = jax.nn.silu(u) * jax.nn.silu(z)
    return u @ w_out


def na_project(h, w_in):
    B, L, _ = h.shape
    q, k, v, z = jnp.split(h @ w_in, 4, axis=-1)
    heads = lambda t: t.reshape(B, L, N_HEADS, HEAD_DIM)
    return heads(q), heads(k), heads(v), z


def context_attention(q, k, v):
    B, L, H, Dh = q.shape
    nb = L // Q_BLOCK
    q = q * (HEAD_DIM ** -0.5)
    qb = q.reshape(B, nb, Q_BLOCK, H, Dh).swapaxes(0, 1)

    def attend(qi):
        s = jnp.einsum('bqhd,bkhd->bhqk', qi, k).astype(jnp.float32)
        p = jax.nn.softmax(s, axis=-1).astype(v.dtype)
        return jnp.einsum('bhqk,bkhd->bqhd', p, v)

    o = lax.map(attend, qb)
    return o.swapaxes(0, 1).reshape(B, L, H * Dh)


def neighbourhood_attention(q, k, v, k_ctx, v_ctx, rpb):
    B, N, H, Dh = q.shape
    rows = N // GRID_W
    kr = min(NA_ROW_WIN, rows)
    kc = NA_COL_WIN
    ncb = GRID_W // kc
    kc2 = 2 * kc
    blk_start = np.clip(np.arange(ncb) * kc - kc // 2, 0, GRID_W - kc2)
    key_col = blk_start[:, None] + np.arange(kc2)[None, :]
    q_col = np.arange(GRID_W).reshape(ncb, kc)
    q_start = np.clip(q_col - kc // 2, 0, GRID_W - kc)
    in_win = (key_col[:, None, :] >= q_start[..., None]) & (key_col[:, None, :] < q_start[..., None] + kc)
    dc_idx = np.clip(key_col[:, None, :] - q_col[..., None] + kc - 1, 0, 2 * kc - 2)
    mask = jnp.asarray(in_win)[:, :, None, :]

    q = q * (HEAD_DIM ** -0.5)
    k_grid = k.reshape(B, rows, GRID_W, H, Dh)
    v_grid = v.reshape(B, rows, GRID_W, H, Dh)
    q_rows = q.reshape(B, rows, ncb, kc, H, Dh).swapaxes(0, 1)
    n_loc = kr * kc2

    def row_block(args):
        r, qb = args
        rs = jnp.clip(r - kr // 2, 0, rows - kr)
        k_rows = lax.dynamic_slice_in_dim(k_grid, rs, kr, axis=1)
        v_rows = lax.dynamic_slice_in_dim(v_grid, rs, kr, axis=1)
        k_blk = k_rows[:, :, key_col]
        v_blk = v_rows[:, :, key_col]
        s_loc = jnp.einsum('bjqhd,brjkhd->bhjqrk', qb, k_blk).astype(jnp.float32)
        dr_idx = rs + jnp.arange(kr) - r + NA_ROW_WIN - 1
        bias = rpb[:, dr_idx][:, :, dc_idx]
        bias = bias.transpose(0, 2, 3, 1, 4).astype(jnp.float32)
        s_loc = jnp.where(mask, s_loc + bias, NEG_INF).reshape(B, H, ncb, kc, n_loc)
        s_ctx = jnp.einsum('bjqhd,blhd->bhjql', qb, k_ctx).astype(jnp.float32)
        p = jax.nn.softmax(jnp.concatenate([s_loc, s_ctx], axis=-1), axis=-1).astype(v.dtype)
        p_loc = p[..., :n_loc].reshape(B, H, ncb, kc, kr, kc2)
        p_ctx = p[..., n_loc:]
        o = (jnp.einsum('bhjqrk,brjkhd->bjqhd', p_loc, v_blk)
             + jnp.einsum('bhjql,blhd->bjqhd', p_ctx, v_ctx))
        return o.reshape(B, GRID_W, H * Dh)

    out = lax.map(row_block, (jnp.arange(rows), q_rows))
    return out.swapaxes(0, 1).reshape(B, N, H * Dh)


def setup_inputs(seed: int = 0) -> dict:
    key = jax.random.key(seed)
    ks = jax.random.split(key, 20)
    f32 = jnp.float32
    nrm = lambda k, shape, s: jax.random.normal(k, shape, f32) * s
    return {
        'x_prompt': nrm(ks[0], (BATCH, SEQ, D_MODEL), 1.0),
        'x_sample': nrm(ks[1], (DEC_BATCH, DEC_SEQ, D_MODEL), 1.0),
        'c': nrm(ks[2], (DEC_BATCH, D_MODEL), 1.0),
        'cache_k': nrm(ks[3], (DEC_BATCH, N_NA_LAYERS, PAST_LEN, N_HEADS, HEAD_DIM), 1.0),
        'cache_v': nrm(ks[4], (DEC_BATCH, N_NA_LAYERS, PAST_LEN, N_HEADS, HEAD_DIM), 1.0),
        'c_ctx': nrm(ks[5], (D_MODEL,), 1.0),
        'norm_g': 1.0 + nrm(ks[6], (DEPTH, D_MODEL), 0.02),
        'ada_w': nrm(ks[7], (DEPTH, D_MODEL, 3 * D_MODEL), 0.5 * D_MODEL ** -0.5),
        'ada_b': nrm(ks[8], (DEPTH, 3 * D_MODEL), 0.02),
        'conv_w_in': nrm(ks[9], (N_CONV_LAYERS, D_MODEL, 3 * CONV_WIDTH), D_MODEL ** -0.5),
        'conv_dw_w': nrm(ks[10], (N_CONV_LAYERS, CONV_K, CONV_WIDTH), CONV_K ** -0.5),
        'conv_dw_b': nrm(ks[11], (N_CONV_LAYERS, CONV_WIDTH), 0.02),
        'conv_ln_g': 1.0 + nrm(ks[12], (N_CONV_LAYERS, CONV_WIDTH), 0.02),
        'conv_ln_b': nrm(ks[13], (N_CONV_LAYERS, CONV_WIDTH), 0.02),
        'conv_w_out': nrm(ks[14], (N_CONV_LAYERS, CONV_WIDTH, D_MODEL), CONV_WIDTH ** -0.5),
        'na_w_in': nrm(ks[15], (N_NA_LAYERS, D_MODEL, 4 * NA_WIDTH), D_MODEL ** -0.5),
        'na_rpb': nrm(ks[16], (N_NA_LAYERS, N_HEADS, 2 * NA_ROW_WIN - 1, 2 * NA_COL_WIN - 1), 0.1),
        'na_w_out': nrm(ks[17], (N_NA_LAYERS, NA_WIDTH, D_MODEL), NA_WIDTH ** -0.5),
        'final_g': 1.0 + nrm(ks[18], (D_MODEL,), 0.02),
    }


def reference(x_prompt, x_sample, c, cache_k, cache_v, c_ctx, norm_g, ada_w, ada_b,
              conv_w_in, conv_dw_w, conv_dw_b, conv_ln_g, conv_ln_b, conv_w_out,
              na_w_in, na_rpb, na_w_out, final_g):
    x = x_prompt
    new_k, new_v = [], []
    for i in range(DEPTH):
        shift, scale, gate = ada_params(c_ctx[None], ada_w[i], ada_b[i])
        h = modulate(x, norm_g[i], shift, scale)
        j = i // N_MIXERS
        if i % N_MIXERS == 0:
            out = conv_branch(h, conv_w_in[j], conv_dw_w[j], conv_dw_b[j],
                              conv_ln_g[j], conv_ln_b[j], conv_w_out[j])
        else:
            q, k, v, z = na_project(h, na_w_in[j])
            new_k.append(k)
            new_v.append(v)
            out = (context_attention(q, k, v) * jax.nn.silu(z)) @ na_w_out[j]
        x = x + gate[:, None] * out
    y_prompt = rms_norm(x, final_g)
    new_cache_k = jnp.stack(new_k, axis=1)
    new_cache_v = jnp.stack(new_v, axis=1)

    x = x_sample
    for i in range(DEPTH):
        shift, scale, gate = ada_params(c, ada_w[i], ada_b[i])
        h = modulate(x, norm_g[i], shift, scale)
        j = i // N_MIXERS
        if i % N_MIXERS == 0:
            out = conv_branch(h, conv_w_in[j], conv_dw_w[j], conv_dw_b[j],
                              conv_ln_g[j], conv_ln_b[j], conv_w_out[j])
        else:
            q, k, v, z = na_project(h, na_w_in[j])
            att = neighbourhood_attention(q, k, v, cache_k[:, j], cache_v[:, j], na_rpb[j])
            out = (att * jax.nn.silu(z)) @ na_w_out[j]
        x = x + gate[:, None] * out
    y_sample = rms_norm(x, final_g)
    return (y_prompt, y_sample, new_cache_k, new_cache_v)
```

```cpp
#include <hip/hip_runtime.h>
#include <cstdint>
#include <cstdio>

constexpr int D = 1024, NCTX_B = 16, SEQ = 256, DEPTH = 4, NLAT_B = 4, LSEQ = 2048, PAST = 512;
constexpr int NCTX = NCTX_B * SEQ;
constexpr int NLAT = NLAT_B * LSEQ;
constexpr int NTOK = NCTX + NLAT;
constexpr int GW = 64, H = 16, DH = 64, CK = 31;
constexpr float EPS = 1e-6f;

__device__ __forceinline__ float silu_f(float x) { return x / (1.f + __expf(-x)); }
__device__ __forceinline__ float sigm_f(float x) { return 1.f / (1.f + __expf(-x)); }
__device__ __forceinline__ int mg_of(int t) { return t < NCTX ? 0 : 1 + (t - NCTX) / LSEQ; }

__global__ void k_ada(const float* __restrict__ c, const float* __restrict__ c_ctx, const float* __restrict__ ada_w,
                      const float* __restrict__ ada_b, float* __restrict__ mod) {
    int n = blockIdx.x * 256 + threadIdx.x;
    int layer = blockIdx.y, v = blockIdx.z;
    const float* cv = v == 0 ? c_ctx : c + (v - 1) * D;
    const float* w = ada_w + (size_t)layer * D * 3 * D;
    float acc = 0.f;
    for (int k = 0; k < D; ++k) acc += silu_f(cv[k]) * w[(size_t)k * 3 * D + n];
    mod[((size_t)v * DEPTH + layer) * 3 * D + n] = acc + ada_b[layer * 3 * D + n];
}

__global__ void k_rowstat(const float* __restrict__ x, float* __restrict__ r) {
    int t = blockIdx.x;
    const float* xr = x + (size_t)t * D;
    float s = 0.f;
    for (int i = threadIdx.x; i < D; i += 256) { float v = xr[i]; s += v * v; }
    __shared__ float red[256];
    red[threadIdx.x] = s; __syncthreads();
    for (int o = 128; o > 0; o >>= 1) { if (threadIdx.x < o) red[threadIdx.x] += red[threadIdx.x + o]; __syncthreads(); }
    if (threadIdx.x == 0) r[t] = rsqrtf(red[0] / D + EPS);
}

template <int MODE>
__global__ void __launch_bounds__(256) k_gemm(const float* __restrict__ A, const float* __restrict__ W, int N,
                                               const float* __restrict__ r, const float* __restrict__ ng,
                                               const float* __restrict__ mod  ,
                                               float* __restrict__ out) {
    __shared__ float sA[16][64 + 1];
    __shared__ float sB[16][64 + 1];
    const int t0 = blockIdx.y * 64, n0 = blockIdx.x * 64;
    const int tx = threadIdx.x & 15, ty = threadIdx.x >> 4;
    float acc[4][4] = {};
    for (int k0 = 0; k0 < D; k0 += 16) {
        for (int e = threadIdx.x; e < 64 * 16; e += 256) {
            int rr = e / 16, kk = e % 16;
            int t = t0 + rr, k = k0 + kk;
            float a = A[(size_t)t * D + k];
            if (MODE == 0) {
                const float* m = mod + (size_t)mg_of(t) * DEPTH * 3 * D;
                a = a * r[t] * ng[k] * (1.f + m[D + k]) + m[k];
            }
            sA[kk][rr] = a;
        }
        for (int e = threadIdx.x; e < 64 * 16; e += 256) {
            int kk = e / 64, nn = e % 64;
            sB[kk][nn] = W[(size_t)(k0 + kk) * N + n0 + nn];
        }
        __syncthreads();
#pragma unroll
        for (int kk = 0; kk < 16; ++kk) {
            float a[4], b[4];
#pragma unroll
            for (int i = 0; i < 4; ++i) a[i] = sA[kk][ty * 4 + i];
#pragma unroll
            for (int j = 0; j < 4; ++j) b[j] = sB[kk][tx * 4 + j];
#pragma unroll
            for (int i = 0; i < 4; ++i)
#pragma unroll
                for (int j = 0; j < 4; ++j) acc[i][j] += a[i] * b[j];
        }
        __syncthreads();
    }
#pragma unroll
    for (int i = 0; i < 4; ++i)
#pragma unroll
        for (int j = 0; j < 4; ++j) {
            int t = t0 + ty * 4 + i, n = n0 + tx * 4 + j;
            if (MODE == 0) {
                out[(size_t)(n / D) * NTOK * D + (size_t)t * D + (n % D)] = acc[i][j];
            } else {
                const float* m = mod + (size_t)mg_of(t) * DEPTH * 3 * D;
                out[(size_t)t * D + n] += m[2 * D + n] * acc[i][j];
            }
        }
}

__global__ void __launch_bounds__(256) k_conv(const float* __restrict__ bufs, const float* __restrict__ dw_w, const float* __restrict__ dw_b,
                                               const float* __restrict__ ln_g, const float* __restrict__ ln_b, float* __restrict__ g) {
    const int t = blockIdx.x;
    int s0, len;
    if (t < NCTX) { s0 = (t / SEQ) * SEQ; len = SEQ; } else { s0 = NCTX + ((t - NCTX) / LSEQ) * LSEQ; len = LSEQ; }
    const int l = t - s0;
    const float* a = bufs; const float* b = bufs + (size_t)NTOK * D; const float* z = bufs + 2 * (size_t)NTOK * D;
    float v[4]; float s = 0.f;
#pragma unroll
    for (int i = 0; i < 4; ++i) {
        int c = threadIdx.x + i * 256;
        float acc = dw_b[c];
        for (int k = 0; k < CK; ++k) {
            int ll = l + k - CK / 2;
            if (ll >= 0 && ll < len) {
                size_t o = (size_t)(s0 + ll) * D + c;
                acc += a[o] * sigm_f(b[o]) * dw_w[k * D + c];
            }
        }
        v[i] = acc; s += acc;
    }
    __shared__ float red[256];
    red[threadIdx.x] = s; __syncthreads();
    for (int o = 128; o > 0; o >>= 1) { if (threadIdx.x < o) red[threadIdx.x] += red[threadIdx.x + o]; __syncthreads(); }
    const float mu = red[0] / D; __syncthreads();
    float q = 0.f;
#pragma unroll
    for (int i = 0; i < 4; ++i) { float d = v[i] - mu; q += d * d; }
    red[threadIdx.x] = q; __syncthreads();
    for (int o = 128; o > 0; o >>= 1) { if (threadIdx.x < o) red[threadIdx.x] += red[threadIdx.x + o]; __syncthreads(); }
    const float rstd = rsqrtf(red[0] / D + EPS);
#pragma unroll
    for (int i = 0; i < 4; ++i) {
        int c = threadIdx.x + i * 256;
        float u = (v[i] - mu) * rstd * ln_g[c] + ln_b[c];
        g[(size_t)t * D + c] = silu_f(u) * silu_f(z[(size_t)t * D + c]);
    }
}

__global__ void __launch_bounds__(256) k_ctx_attn(float* __restrict__ bufs, float* __restrict__ newk, float* __restrict__ newv, int j) {
    const int t = blockIdx.x, h = blockIdx.y;
    const int b = t / SEQ, s = t % SEQ;
    float* q = bufs; const float* k = bufs + (size_t)NTOK * D; const float* v = bufs + 2 * (size_t)NTOK * D; const float* z = bufs + 3 * (size_t)NTOK * D;
    __shared__ float sq[DH]; __shared__ float sp[SEQ]; __shared__ float red[256];
    if (threadIdx.x < DH) sq[threadIdx.x] = q[(size_t)t * D + h * DH + threadIdx.x] * 0.125f;
    __syncthreads();
    const int l = threadIdx.x;
    const float* kr = k + (size_t)(b * SEQ + l) * D + h * DH;
    float sc = 0.f;
    for (int d = 0; d < DH; ++d) sc += sq[d] * kr[d];
    red[threadIdx.x] = sc; __syncthreads();
    for (int o = 128; o > 0; o >>= 1) { if (threadIdx.x < o) red[threadIdx.x] = fmaxf(red[threadIdx.x], red[threadIdx.x + o]); __syncthreads(); }
    const float mx = red[0]; __syncthreads();
    const float p = __expf(sc - mx);
    sp[l] = p; red[threadIdx.x] = p; __syncthreads();
    for (int o = 128; o > 0; o >>= 1) { if (threadIdx.x < o) red[threadIdx.x] += red[threadIdx.x + o]; __syncthreads(); }
    const float inv = 1.f / red[0];
    if (threadIdx.x < DH) {
        const int d = threadIdx.x;
        float o = 0.f;
        for (int ll = 0; ll < SEQ; ++ll) o += sp[ll] * v[(size_t)(b * SEQ + ll) * D + h * DH + d];
        o *= inv;
        size_t idx = (size_t)t * D + h * DH + d;
        q[idx] = o * silu_f(z[idx]);
        size_t oc = ((size_t)(b * 2 + j) * SEQ + s) * D + h * DH + d;
        newk[oc] = k[idx]; newv[oc] = v[idx];
    }
}

__global__ void __launch_bounds__(256) k_na_attn(float* __restrict__ bufs, const float* __restrict__ cache_k, const float* __restrict__ cache_v,
                                                  const float* __restrict__ rpb, int j) {
    const int tl = blockIdx.x, h = blockIdx.y;
    const int b = tl / LSEQ, n = tl % LSEQ, r = n / GW, c = n % GW;
    const int t = NCTX + tl;
    float* q = bufs; const float* k = bufs + (size_t)NTOK * D; const float* v = bufs + 2 * (size_t)NTOK * D; const float* z = bufs + 3 * (size_t)NTOK * D;
    __shared__ float sq[DH]; __shared__ float sp[128 + PAST]; __shared__ float red[256];
    if (threadIdx.x < DH) sq[threadIdx.x] = q[(size_t)t * D + h * DH + threadIdx.x] * 0.125f;
    __syncthreads();
    int rs = r - 4; rs = rs < 0 ? 0 : (rs > 24 ? 24 : rs);
    int qs = c - 8; qs = qs < 0 ? 0 : (qs > 48 ? 48 : qs);
    const float* ck = cache_k + ((size_t)(b * 2 + j) * PAST) * D + h * DH;
    const float* cv = cache_v + ((size_t)(b * 2 + j) * PAST) * D + h * DH;
    const float* rp = rpb + ((size_t)j * H + h) * 15 * 31;
    float mx = -3.0e38f;
    for (int i = threadIdx.x; i < 128 + PAST; i += 256) {
        float sc = 0.f;
        if (i < 128) {
            int rr = rs + i / 16, kc = qs + i % 16;
            const float* kr = k + (size_t)(NCTX + b * LSEQ + rr * GW + kc) * D + h * DH;
            for (int d = 0; d < DH; ++d) sc += sq[d] * kr[d];
            int dr = rr - r + 7, dc = kc - c + 15;
            dc = dc < 0 ? 0 : (dc > 30 ? 30 : dc);
            sc += rp[dr * 31 + dc];
        } else {
            const float* kr = ck + (size_t)(i - 128) * D;
            for (int d = 0; d < DH; ++d) sc += sq[d] * kr[d];
        }
        sp[i] = sc; mx = fmaxf(mx, sc);
    }
    red[threadIdx.x] = mx; __syncthreads();
    for (int o = 128; o > 0; o >>= 1) { if (threadIdx.x < o) red[threadIdx.x] = fmaxf(red[threadIdx.x], red[threadIdx.x + o]); __syncthreads(); }
    mx = red[0]; __syncthreads();
    float ps = 0.f;
    for (int i = threadIdx.x; i < 128 + PAST; i += 256) { float p = __expf(sp[i] - mx); sp[i] = p; ps += p; }
    red[threadIdx.x] = ps; __syncthreads();
    for (int o = 128; o > 0; o >>= 1) { if (threadIdx.x < o) red[threadIdx.x] += red[threadIdx.x + o]; __syncthreads(); }
    const float inv = 1.f / red[0];
    if (threadIdx.x < DH) {
        const int d = threadIdx.x;
        float o = 0.f;
        for (int i = 0; i < 128; ++i) {
            int rr = rs + i / 16, kc = qs + i % 16;
            o += sp[i] * v[(size_t)(NCTX + b * LSEQ + rr * GW + kc) * D + h * DH + d];
        }
        for (int i = 0; i < PAST; ++i) o += sp[128 + i] * cv[(size_t)i * D + d];
        o *= inv;
        size_t idx = (size_t)t * D + h * DH + d;
        q[idx] = o * silu_f(z[idx]);
    }
}

__global__ void k_final(float* __restrict__ x, const float* __restrict__ r, const float* __restrict__ fg) {
    int t = blockIdx.x;
    for (int i = threadIdx.x; i < D; i += 256) x[(size_t)t * D + i] = x[(size_t)t * D + i] * r[t] * fg[i];
}

extern "C" void kernel_launch(void* const* d_in, const int* in_sizes, int n_in, void* d_out, int out_size, void* d_ws, size_t ws_size,
                              hipStream_t stream) {
    const float* x_prompt = (const float*)d_in[0]; const float* x_sample = (const float*)d_in[1];
    const float* c = (const float*)d_in[2]; const float* cache_k = (const float*)d_in[3]; const float* cache_v = (const float*)d_in[4];
    const float* c_ctx = (const float*)d_in[5]; const float* norm_g = (const float*)d_in[6]; const float* ada_w = (const float*)d_in[7];
    const float* ada_b = (const float*)d_in[8]; const float* conv_w_in = (const float*)d_in[9]; const float* conv_dw_w = (const float*)d_in[10];
    const float* conv_dw_b = (const float*)d_in[11]; const float* conv_ln_g = (const float*)d_in[12]; const float* conv_ln_b = (const float*)d_in[13];
    const float* conv_w_out = (const float*)d_in[14]; const float* na_w_in = (const float*)d_in[15]; const float* na_rpb = (const float*)d_in[16];
    const float* na_w_out = (const float*)d_in[17]; const float* final_g = (const float*)d_in[18];
    float* out = (float*)d_out;
    float* x = out;
    float* newk = out + (size_t)NTOK * D;
    float* newv = newk + (size_t)NCTX_B * 2 * SEQ * D;
    char* ws = (char*)d_ws;
    float* mod = (float*)ws;
    float* r = (float*)(ws + (1 << 20));
    float* bufs = (float*)(ws + (2 << 20));

    hipMemcpyAsync(x, x_prompt, (size_t)NCTX * D * 4, hipMemcpyDeviceToDevice, stream);
    hipMemcpyAsync(x + (size_t)NCTX * D, x_sample, (size_t)NLAT * D * 4, hipMemcpyDeviceToDevice, stream);
    k_ada<<<dim3(12, DEPTH, 5), 256, 0, stream>>>(c, c_ctx, ada_w, ada_b, mod);
    for (int i = 0; i < DEPTH; ++i) {
        const int j = i / 2;
        const float* m = mod + (size_t)i * 3 * D;
        k_rowstat<<<NTOK, 256, 0, stream>>>(x, r);
        if (i % 2 == 0) {
            k_gemm<0><<<dim3(3 * D / 64, NTOK / 64), 256, 0, stream>>>(x, conv_w_in + (size_t)j * D * 3 * D, 3 * D, r, norm_g + i * D, m, bufs);
            k_conv<<<NTOK, 256, 0, stream>>>(bufs, conv_dw_w + (size_t)j * CK * D, conv_dw_b + j * D, conv_ln_g + j * D, conv_ln_b + j * D,
                                             bufs + 3 * (size_t)NTOK * D);
            k_gemm<1><<<dim3(D / 64, NTOK / 64), 256, 0, stream>>>(bufs + 3 * (size_t)NTOK * D, conv_w_out + (size_t)j * D * D, D, nullptr, nullptr, m, x);
        } else {
            k_gemm<0><<<dim3(4 * D / 64, NTOK / 64), 256, 0, stream>>>(x, na_w_in + (size_t)j * D * 4 * D, 4 * D, r, norm_g + i * D, m, bufs);
            k_ctx_attn<<<dim3(NCTX, H), 256, 0, stream>>>(bufs, newk, newv, j);
            k_na_attn<<<dim3(NLAT, H), 256, 0, stream>>>(bufs, cache_k, cache_v, na_rpb, j);
            k_gemm<1><<<dim3(D / 64, NTOK / 64), 256, 0, stream>>>(bufs, na_w_out + (size_t)j * D * D, D, nullptr, nullptr, m, x);
        }
    }
    k_rowstat<<<NTOK, 256, 0, stream>>>(x, r);
    k_final<<<NTOK, 256, 0, stream>>>(x, r, final_g);
}
```

```cpp
#include <hip/hip_runtime.h>
#include <cstdio>
#include <cstdint>
namespace pg8 {
#define PG8_LAS __attribute__((address_space(3)))
typedef unsigned short bf16_t;
typedef short bf16x8 __attribute__((ext_vector_type(8)));
typedef float f32x4 __attribute__((ext_vector_type(4)));
typedef unsigned u32x4 __attribute__((ext_vector_type(4)));
constexpr int BM = 256, BK = 64, HALF = 128, HTB = HALF * BK * 2  , STAGE_BYTES = 8 * HTB, NXCD = 8, WGM = 8;

__host__ __device__ __forceinline__ int lds_byte(int r, int c) { const int st = (r >> 4) * 2 + (c >> 5), rr = r & 15, cc = c & 31, ob = rr * 64 + cc * 2; return st * 1024 + (ob ^ (((ob >> 9) & 1) << 5)); }
__host__ __device__ __forceinline__ void stage_rc(int b, int& R, int& C) { const int st = b / 1024, sb = b % 1024, swz = sb ^ (((sb >> 9) & 1) << 5); R = (st >> 1) * 16 + swz / 64; C = (st & 1) * 32 + (swz % 64) / 2; }
__host__ __device__ __forceinline__ int perm32(int rho) { const int n = rho >> 4, i = rho & 15; return 8 * (i >> 2) + 4 * n + (i & 3); }

struct Unit { int pm, pn; };
struct Gemm { const bf16_t* A; const bf16_t* Bt; int M, N, K; };

struct StaticOrder {
    int nM, nN, nwg, G, c;
    __host__ __device__ void init(int M, int N, int G_, int c_) { nM = M / BM; nN = N / BM; nwg = nM * nN; G = G_; c = c_; }
    __host__ __device__ bool next(int i, Unit& u) const {
        const long L = (long)i * G + c; if (L >= nwg) return false;
        int wgid = (int)L; { const int q = nwg / NXCD, r = nwg % NXCD, xcd = wgid % NXCD, off = wgid / NXCD; wgid = (xcd < r ? xcd * (q + 1) : r * (q + 1) + (xcd - r) * q) + off; }
        const int nig = WGM * nN, gid = wgid / nig, fm = gid * WGM, gsz = (nM - fm) < WGM ? (nM - fm) : WGM;
        u.pm = fm + ((wgid % nig) % gsz); u.pn = (wgid % nig) / gsz; return true;
    }
    __device__ __forceinline__ void a_ready(const Unit&) const {}
    __device__ __forceinline__ void done(const Unit&) const {}
};


__device__ __forceinline__ unsigned cvt_pk_bf16(float lo, float hi) { unsigned r; asm volatile("v_cvt_pk_bf16_f32 %0, %1, %2" : "=v"(r) : "v"(lo), "v"(hi)); return r; }
constexpr int ROWLEN = 1024;
constexpr int NTOKC = 4096;
constexpr float RMS_EPS = 1e-6f;
constexpr float LOG2E = 1.4426950408889634f;
constexpr float QSCALE = 0.125f * LOG2E;
__device__ __forceinline__ int mg_of_tile(int pm) { return pm < 16 ? 0 : 1 + ((pm - 16) >> 3); }
__device__ __forceinline__ float fast_sigmoid(float x) { return __builtin_amdgcn_rcpf(1.0f + __builtin_amdgcn_exp2f(-LOG2E * x)); }
__device__ __forceinline__ f32x4 sigm4(f32x4 v) { return (f32x4){fast_sigmoid(v[0]), fast_sigmoid(v[1]), fast_sigmoid(v[2]), fast_sigmoid(v[3])}; }
__device__ __forceinline__ u32x4 pack8(f32x4 a, f32x4 b) { u32x4 w; w.x = cvt_pk_bf16(a[0], a[1]); w.y = cvt_pk_bf16(a[2], a[3]); w.z = cvt_pk_bf16(b[0], b[1]); w.w = cvt_pk_bf16(b[2], b[3]); return w; }
__device__ __forceinline__ float row_rscale(const float* ssp, int row) {
    const f32x4* p = (const f32x4*)(ssp + (size_t)row * 16);
    const f32x4 a = p[0], b = p[1], c = p[2], d = p[3];
    const f32x4 s = (a + b) + (c + d);
    return __builtin_amdgcn_rsqf(((s[0] + s[1]) + (s[2] + s[3])) * (1.0f / ROWLEN) + RMS_EPS);
}

struct EpiConv1 {
    static constexpr bool PERM = true, AFTER_DRAIN = false;
    const float* ssp; const float* bias  ; bf16_t* U; bf16_t* SZ;
    __device__ __forceinline__ void operator()(const f32x4 (&acc)[2][2][4][2], const Unit& u, int wr, int wc, int fr, int fq) const {
        const int mg = mg_of_tile(u.pm);
        const float* bb = bias + mg * 4096 + u.pn * BM + wc * 32 + 8 * fq;
        f32x4 bv[2][2];
#pragma unroll
        for (int bj = 0; bj < 2; ++bj)
#pragma unroll
            for (int n = 0; n < 2; ++n) bv[bj][n] = *(const f32x4*)(bb + bj * HALF + 4 * n);
        const int row0 = u.pm * BM + wr * 64 + fr;
        if (u.pn < 8) {
            const int col = u.pn * HALF + wc * 32 + 8 * fq;
#pragma unroll
            for (int ai = 0; ai < 2; ++ai)
#pragma unroll
                for (int m = 0; m < 4; ++m) { const int row = row0 + ai * HALF + m * 16; const float rs = row_rscale(ssp, row);
                    const f32x4 a0 = acc[ai][0][m][0] * rs + bv[0][0], a1 = acc[ai][0][m][1] * rs + bv[0][1];
                    const f32x4 b0 = acc[ai][1][m][0] * rs + bv[1][0], b1 = acc[ai][1][m][1] * rs + bv[1][1];
                    *(u32x4*)(U + (size_t)row * ROWLEN + col) = pack8(a0 * sigm4(b0), a1 * sigm4(b1)); }
        } else {
            const int col = (u.pn - 8) * BM + wc * 32 + 8 * fq;
#pragma unroll
            for (int ai = 0; ai < 2; ++ai)
#pragma unroll
                for (int m = 0; m < 4; ++m) { const int row = row0 + ai * HALF + m * 16; const float rs = row_rscale(ssp, row);
#pragma unroll
                    for (int bj = 0; bj < 2; ++bj) { const f32x4 z0 = acc[ai][bj][m][0] * rs + bv[bj][0], z1 = acc[ai][bj][m][1] * rs + bv[bj][1];
                        *(u32x4*)(SZ + (size_t)row * ROWLEN + col + bj * HALF) = pack8(z0 * sigm4(z0), z1 * sigm4(z1)); } }
        }
    }
};

struct EpiAttn1 {
    static constexpr bool PERM = true, AFTER_DRAIN = false;
    const float* ssp; const float* bias; bf16_t* B0; size_t bstride  ; float* newk; size_t nstride  ; int j;
    __device__ __forceinline__ void operator()(const f32x4 (&acc)[2][2][4][2], const Unit& u, int wr, int wc, int fr, int fq) const {
        const int mg = mg_of_tile(u.pm);
        const float* bb = bias + mg * 4096 + u.pn * BM + wc * 32 + 8 * fq;
        f32x4 bv[2][2];
#pragma unroll
        for (int bj = 0; bj < 2; ++bj)
#pragma unroll
            for (int n = 0; n < 2; ++n) bv[bj][n] = *(const f32x4*)(bb + bj * HALF + 4 * n);
        const int row0 = u.pm * BM + wr * 64 + fr;
        const int sect = u.pn >> 2, col = (u.pn & 3) * BM + wc * 32 + 8 * fq;
        const int bidx = sect == 0 ? 0 : (sect == 3 ? 1 : sect + 1);
        bf16_t* dst = B0 + (size_t)bidx * bstride;
        float* cdst = newk + (sect == 2 ? nstride : (size_t)0);
        const bool cache = (sect == 1 || sect == 2) && u.pm < 16;
        const float qs = sect == 0 ? QSCALE : 1.0f;
#pragma unroll
        for (int ai = 0; ai < 2; ++ai)
#pragma unroll
            for (int m = 0; m < 4; ++m) { const int row = row0 + ai * HALF + m * 16; const float rs = row_rscale(ssp, row);
#pragma unroll
                for (int bj = 0; bj < 2; ++bj) { f32x4 v0 = acc[ai][bj][m][0] * rs + bv[bj][0], v1 = acc[ai][bj][m][1] * rs + bv[bj][1];
                    if (cache) { float* cp = cdst + ((size_t)(u.pm * 2 + j) * 256 + (row - u.pm * BM)) * ROWLEN + col + bj * HALF; *(f32x4*)cp = v0; *(f32x4*)(cp + 4) = v1; }
                    v0 = v0 * qs; v1 = v1 * qs;
                    if (sect == 3) { v0 = v0 * sigm4(v0); v1 = v1 * sigm4(v1); }
                    *(u32x4*)(dst + (size_t)row * ROWLEN + col + bj * HALF) = pack8(v0, v1); } }
    }
};

template <bool HAS_NEXT> struct EpiGemm2 {
    static constexpr bool PERM = true, AFTER_DRAIN = false;
    const float* base_ctx; const float* base_lat; float* out; const float* gate  ; int gate_stride; const float* gsn  ; bf16_t* XS; float* ssp;
    __device__ __forceinline__ void operator()(const f32x4 (&acc)[2][2][4][2], const Unit& u, int wr, int wc, int fr, int fq) const {
        const int mg = mg_of_tile(u.pm);
        const int col = u.pn * BM + wc * 32 + 8 * fq;
        f32x4 gv[2][2], sv[2][2];
#pragma unroll
        for (int bj = 0; bj < 2; ++bj)
#pragma unroll
            for (int n = 0; n < 2; ++n) { gv[bj][n] = *(const f32x4*)(gate + (size_t)mg * gate_stride + col + bj * HALF + 4 * n);
                if (HAS_NEXT) sv[bj][n] = *(const f32x4*)(gsn + mg * ROWLEN + col + bj * HALF + 4 * n); }
        const int row0 = u.pm * BM + wr * 64 + fr;
        const float* base = u.pm < 16 ? base_ctx : base_lat - (size_t)NTOKC * ROWLEN;
#pragma unroll
        for (int ai = 0; ai < 2; ++ai)
#pragma unroll
            for (int m = 0; m < 4; ++m) { const int row = row0 + ai * HALF + m * 16; float sq = 0.f;
#pragma unroll
                for (int bj = 0; bj < 2; ++bj) { const size_t off = (size_t)row * ROWLEN + col + bj * HALF;
                    const f32x4 x0 = *(const f32x4*)(base + off) + gv[bj][0] * acc[ai][bj][m][0], x1 = *(const f32x4*)(base + off + 4) + gv[bj][1] * acc[ai][bj][m][1];
                    *(f32x4*)(out + off) = x0; *(f32x4*)(out + off + 4) = x1;
                    sq += (x0[0] * x0[0] + x0[1] * x0[1]) + (x0[2] * x0[2] + x0[3] * x0[3]) + (x1[0] * x1[0] + x1[1] * x1[1]) + (x1[2] * x1[2] + x1[3] * x1[3]);
                    if (HAS_NEXT) *(u32x4*)(XS + off) = pack8(x0 * sv[bj][0], x1 * sv[bj][1]); }
                sq += __shfl_xor(sq, 16); sq += __shfl_xor(sq, 32);
                if (fq == 0) ssp[(size_t)row * 16 + u.pn * 4 + wc] = sq; }
    }
};
template <class Epi, class Sched, bool ALIGN_EPI = false, bool SP2 = false>
__device__ __forceinline__ void gemm_phase(PG8_LAS unsigned char* lds, const Gemm g, const Sched& S, const Epi& E) {
    int tid_ = threadIdx.x; asm volatile("" : "+v"(tid_));
    const int tid = tid_, wid = __builtin_amdgcn_readfirstlane(tid >> 6), lane = tid & 63, wr = wid >> 2, wc = wid & 3, fr = lane & 15, fq = lane >> 4;
    const int K = g.K, nt = K / BK;
    unsigned voffA[2], voffB[2];
#pragma unroll
    for (int i = 0; i < 2; ++i) { int R, C; stage_rc(tid * 16 + i * 8192, R, C); const int Rb = Epi::PERM ? ((R & ~31) + perm32(R & 31)) : R;
        voffA[i] = (unsigned)(R * K + C) * 2u; voffB[i] = (unsigned)(Rb * K + C) * 2u; }
    const size_t kstep = (size_t)(BK * 2);
    const size_t hstep = (size_t)HALF * K * 2;
    const size_t tstep = 2 * hstep;
    const unsigned ldsw = (unsigned)wid * 1024u;
    const int aoff = lds_byte(wr * 64 + fr, fq * 8), boff = lds_byte(wc * 32 + fr, fq * 8);
#define PG8_SA(b, h) (((b) * 2 + (h)) * HTB)
#define PG8_SB(b, h) ((4 + (b) * 2 + (h)) * HTB)
#define PG8_STAGE(bufoff, gbase, voff) do { _Pragma("unroll") for (int _i = 0; _i < 2; ++_i) \
        __builtin_amdgcn_global_load_lds((const unsigned*)((const char*)(gbase) + (voff)[_i]), (PG8_LAS unsigned*)(lds + (bufoff) + ldsw + _i * 8192), 16, 0, 0); } while (0)
#define PG8_LDA(dst, b, h) do { _Pragma("unroll") for (int m = 0; m < 4; ++m) _Pragma("unroll") for (int k = 0; k < 2; ++k) dst[m][k] = *(const PG8_LAS bf16x8*)(lds + PG8_SA(b, h) + aoff + m * 2048 + k * 1024); } while (0)
#define PG8_LDB(dst, b, h) do { _Pragma("unroll") for (int n = 0; n < 2; ++n) _Pragma("unroll") for (int k = 0; k < 2; ++k) dst[n][k] = *(const PG8_LAS bf16x8*)(lds + PG8_SB(b, h) + boff + n * 2048 + k * 1024); } while (0)
#define PG8_MMA(ai, bj, At, Bt) do { __builtin_amdgcn_s_setprio(1); _Pragma("unroll") for (int m = 0; m < 4; ++m) _Pragma("unroll") for (int n = 0; n < 2; ++n) _Pragma("unroll") for (int k = 0; k < 2; ++k) \
        acc[ai][bj][m][n] = __builtin_amdgcn_mfma_f32_16x16x32_bf16(Bt[n][k], At[m][k], acc[ai][bj][m][n], 0, 0, 0); __builtin_amdgcn_s_setprio(0); } while (0)
#define PG8_WAIT_V(n) asm volatile("s_waitcnt vmcnt(" #n ")" ::: "memory")
#define PG8_WAIT_L(n) asm volatile("s_waitcnt lgkmcnt(" #n ")" ::: "memory")
#define PG8_BAR __builtin_amdgcn_s_barrier()
#define PG8_SCHED __builtin_amdgcn_sched_barrier(0)
    Unit cur, nxt; int ui = 0;
    if (!S.next(0, cur)) return;
    f32x4 acc[2][2][4][2];
#pragma unroll
    for (int a = 0; a < 2; ++a)
#pragma unroll
        for (int b = 0; b < 2; ++b)
#pragma unroll
            for (int m = 0; m < 4; ++m)
#pragma unroll
                for (int n = 0; n < 2; ++n) acc[a][b][m][n] = (f32x4){0.f, 0.f, 0.f, 0.f};
    bf16x8 At[4][2], B0[2][2], B1[2][2];
    const char* cA = (const char*)g.A + (size_t)cur.pm * tstep; const char* cB = (const char*)g.Bt + (size_t)cur.pn * tstep;
    S.a_ready(cur);
    if constexpr (SP2) {
        PG8_STAGE(PG8_SB(0, 0), cB, voffB); PG8_STAGE(PG8_SB(0, 1), cB + hstep, voffB); PG8_STAGE(PG8_SA(0, 0), cA, voffA); PG8_STAGE(PG8_SA(0, 1), cA + hstep, voffA);
        if (wr == 1) PG8_BAR;
        PG8_WAIT_V(2); PG8_BAR;
        PG8_STAGE(PG8_SB(1, 0), cB + kstep, voffB); PG8_STAGE(PG8_SA(1, 0), cA + kstep, voffA); PG8_STAGE(PG8_SB(1, 1), cB + hstep + kstep, voffB);
        PG8_WAIT_V(6); PG8_BAR;
    } else {
        PG8_STAGE(PG8_SB(0, 0), cB, voffB); PG8_STAGE(PG8_SA(0, 0), cA, voffA); PG8_STAGE(PG8_SB(0, 1), cB + hstep, voffB); PG8_STAGE(PG8_SA(0, 1), cA + hstep, voffA);
        if (wr == 1) PG8_BAR;
        PG8_WAIT_V(4); PG8_BAR;
        PG8_STAGE(PG8_SB(1, 0), cB + kstep, voffB); PG8_STAGE(PG8_SA(1, 0), cA + kstep, voffA); PG8_STAGE(PG8_SB(1, 1), cB + hstep + kstep, voffB);
        PG8_WAIT_V(6); PG8_BAR;
    }
    for (;;) {
        const bool has_next = S.next(ui + 1, nxt);
        const char* nA = has_next ? (const char*)g.A + (size_t)nxt.pm * tstep : cA; const char* nB = has_next ? (const char*)g.Bt + (size_t)nxt.pn * tstep : cB;
        for (int t = 0; t < nt; t += 2) {
            const bool last = (t == nt - 2);
            const char* a1 = cA + (size_t)(t + 1) * kstep;
            const char* a2 = last ? nA : cA + (size_t)(t + 2) * kstep; const char* b2 = last ? nB : cB + (size_t)(t + 2) * kstep;
            const char* a3 = a2 + kstep; const char* b3 = b2 + kstep;
            if (last && has_next) S.a_ready(nxt);
            if constexpr (SP2) {
            PG8_LDB(B0, 0, 0); PG8_LDB(B1, 0, 1); PG8_SCHED; PG8_LDA(At, 0, 0); PG8_STAGE(PG8_SA(1, 1), a1 + hstep, voffA);
            PG8_WAIT_V(8); PG8_WAIT_L(0); PG8_BAR; PG8_MMA(0, 0, At, B0); PG8_MMA(0, 1, At, B1); PG8_BAR; PG8_SCHED;
            PG8_LDA(At, 0, 1); PG8_STAGE(PG8_SB(0, 0), b2, voffB); PG8_STAGE(PG8_SB(0, 1), b2 + hstep, voffB); PG8_STAGE(PG8_SA(0, 0), a2, voffA);
            PG8_WAIT_V(8); PG8_WAIT_L(0); PG8_BAR; PG8_MMA(1, 0, At, B0); PG8_MMA(1, 1, At, B1); PG8_BAR; PG8_SCHED;
            PG8_LDB(B0, 1, 0); PG8_LDB(B1, 1, 1); PG8_SCHED; PG8_LDA(At, 1, 0); PG8_STAGE(PG8_SA(0, 1), a2 + hstep, voffA);
            PG8_WAIT_V(8); PG8_WAIT_L(0); PG8_BAR; PG8_MMA(0, 0, At, B0); PG8_MMA(0, 1, At, B1); PG8_BAR; PG8_SCHED;
            PG8_LDA(At, 1, 1); PG8_STAGE(PG8_SB(1, 0), b3, voffB); PG8_STAGE(PG8_SB(1, 1), b3 + hstep, voffB); PG8_STAGE(PG8_SA(1, 0), a3, voffA);
            PG8_WAIT_V(8); PG8_WAIT_L(0); PG8_BAR; PG8_MMA(1, 0, At, B0); PG8_MMA(1, 1, At, B1); PG8_BAR; PG8_SCHED;
            } else {
            PG8_LDB(B0, 0, 0); PG8_SCHED; PG8_LDA(At, 0, 0); PG8_STAGE(PG8_SA(1, 1), a1 + hstep, voffA);
            PG8_WAIT_L(8); PG8_BAR; PG8_WAIT_L(0); PG8_MMA(0, 0, At, B0); PG8_BAR; PG8_SCHED;
            PG8_LDB(B1, 0, 1); PG8_STAGE(PG8_SB(0, 0), b2, voffB);
            PG8_BAR; PG8_WAIT_L(0); PG8_MMA(0, 1, At, B1); PG8_BAR;
            PG8_LDA(At, 0, 1); PG8_STAGE(PG8_SA(0, 0), a2, voffA);
            PG8_BAR; PG8_WAIT_L(0); PG8_MMA(1, 0, At, B0); PG8_BAR; PG8_SCHED;
            PG8_STAGE(PG8_SB(0, 1), b2 + hstep, voffB);
            PG8_WAIT_V(6); PG8_BAR; PG8_MMA(1, 1, At, B1); PG8_BAR;
            PG8_LDB(B0, 1, 0); PG8_SCHED; PG8_LDA(At, 1, 0); PG8_STAGE(PG8_SA(0, 1), a2 + hstep, voffA);
            PG8_WAIT_L(8); PG8_BAR; PG8_WAIT_L(0); PG8_MMA(0, 0, At, B0); PG8_BAR; PG8_SCHED;
            PG8_LDB(B1, 1, 1); PG8_STAGE(PG8_SB(1, 0), b3, voffB);
            PG8_BAR; PG8_WAIT_L(0); PG8_MMA(0, 1, At, B1); PG8_BAR;
            PG8_LDA(At, 1, 1); PG8_STAGE(PG8_SA(1, 0), a3, voffA);
            PG8_BAR; PG8_WAIT_L(0); PG8_MMA(1, 0, At, B0); PG8_BAR; PG8_SCHED;
            PG8_STAGE(PG8_SB(1, 1), b3 + hstep, voffB);
            PG8_WAIT_V(6); PG8_BAR; PG8_MMA(1, 1, At, B1); PG8_BAR;
            }
        }
        if constexpr (ALIGN_EPI) { if (wr == 0) PG8_BAR; }
        if constexpr (!Epi::AFTER_DRAIN) { E(acc, cur, wr, wc, fr, fq); S.done(cur); }
        if (!has_next) break;
#pragma unroll
        for (int a = 0; a < 2; ++a)
#pragma unroll
            for (int b = 0; b < 2; ++b)
#pragma unroll
                for (int m = 0; m < 4; ++m)
#pragma unroll
                    for (int n = 0; n < 2; ++n) acc[a][b][m][n] = (f32x4){0.f, 0.f, 0.f, 0.f};
        cur = nxt; cA = nA; cB = nB; ++ui;
        if constexpr (ALIGN_EPI) { if (wr == 1) PG8_BAR; }
    }
    PG8_WAIT_V(0);
    if constexpr (!ALIGN_EPI) { if (wr == 0) PG8_BAR; }
    PG8_BAR;
    if constexpr (Epi::AFTER_DRAIN) { E.fused(acc, cur, wr, wc, fr, fq, lds, wid, lane); S.done(cur); }
#undef PG8_SA
#undef PG8_SB
#undef PG8_STAGE
#undef PG8_LDA
#undef PG8_LDB
#undef PG8_MMA
#undef PG8_WAIT_V
#undef PG8_WAIT_L
#undef PG8_BAR
#undef PG8_SCHED
}
}
#define GAS __attribute__((address_space(1)))
#define LAS __attribute__((address_space(3)))
typedef unsigned short bf16;
typedef unsigned v4u __attribute__((ext_vector_type(4)));
typedef float f32x4 __attribute__((ext_vector_type(4)));
typedef short bf16x8 __attribute__((ext_vector_type(8)));
typedef GAS unsigned gu32;
typedef GAS unsigned long long gu64;
#define RLX_AGENT __ATOMIC_RELAXED, __HIP_MEMORY_SCOPE_AGENT
#define LDS_WAIT() asm volatile("s_waitcnt lgkmcnt(0)" ::: "memory")
#define VM_WAIT() asm volatile("s_waitcnt vmcnt(0)" ::: "memory")
__device__ __forceinline__ unsigned long long rt() { return __builtin_amdgcn_s_memrealtime(); }
__device__ __forceinline__ unsigned f2bf(float f) { unsigned u = __builtin_bit_cast(unsigned, f); return (u + 0x7fffu + ((u >> 16) & 1u)) >> 16; }
__device__ __forceinline__ unsigned pk2(float lo, float hi) { return f2bf(lo) | (f2bf(hi) << 16); }

#define XB_TMO      128
#define XB_XCNT(j)  (256  + 64 * (j))
#define XB_XSUB(j)  (1280 + 64 * (j))
#define XB_XGEN(j)  (2304 + 64 * (j))
#define XB_TOP      3328
#define XB_TOPGEN   3392
#define XCD_BAR_WORDS 3456
#define XB_SPIN_CAP (1u << 18)

__device__ __forceinline__ unsigned xb_ld(unsigned* p)              { return __hip_atomic_load(p, __ATOMIC_RELAXED, __HIP_MEMORY_SCOPE_AGENT); }
__device__ __forceinline__ unsigned xb_add(unsigned* p, unsigned v) { return __hip_atomic_fetch_add(p, v, __ATOMIC_RELAXED, __HIP_MEMORY_SCOPE_AGENT); }
__device__ __forceinline__ unsigned xb_xcc_id() { return (unsigned)__builtin_amdgcn_s_getreg((3 << 11) | 20) & 0xFu; }
#define XB_SPIN(cond, bar) do { unsigned _sp = 0; while (cond) { __builtin_amdgcn_s_sleep(1); \
    if ((++_sp & 255u) == 0u) { if (xb_ld(&(bar)[XB_TMO])) break; if (_sp > XB_SPIN_CAP) { atomicAdd(&(bar)[XB_TMO], 1u); break; } } } } while (0)

struct XcdBarrier {
    unsigned* bar; unsigned x;
    volatile LAS unsigned* st;
};

__device__ __forceinline__ XcdBarrier xcd_barrier_post(unsigned* bar, volatile LAS unsigned* st) {
    XcdBarrier b; b.bar = bar; b.x = xb_xcc_id(); b.st = st;
    if (threadIdx.x == 0) (void)xb_add(&bar[XB_XCNT(b.x)], 1u);
    return b;
}
__device__ __forceinline__ void xcd_barrier_complete(unsigned* bar, unsigned x, unsigned& nloc, unsigned& nx) {
    const unsigned G = gridDim.x * gridDim.y * gridDim.z;
    unsigned sum, cnt, mine, sp = 0u;
    for (;;) {
        sum = 0u; cnt = 0u; mine = 0u;
#pragma unroll
        for (unsigned j = 0; j < 16; ++j) { const unsigned c = xb_ld(&bar[XB_XCNT(j)]); sum += c; cnt += (c > 0u) ? 1u : 0u; mine = (j == x) ? c : mine; }
        if (sum == G) break;
        __builtin_amdgcn_s_sleep(1);
        if ((++sp & 255u) == 0u) { if (xb_ld(&bar[XB_TMO])) break; if (sp > XB_SPIN_CAP) { atomicAdd(&bar[XB_TMO], 1u); break; } }
    }
    nloc = mine > 0u ? mine : 1u; nx = cnt > 0u ? cnt : 1u;
}

__device__ __forceinline__ void xcd_barrier(const XcdBarrier& b) {
    asm volatile("s_waitcnt vmcnt(0)" ::: "memory");
    __syncthreads();
    if (threadIdx.x == 0) {
        unsigned* bar = b.bar;
        __builtin_amdgcn_s_waitcnt(0);
        unsigned nloc = b.st[0], nx = b.st[1];
        if (nloc == 0u) { xcd_barrier_complete(bar, b.x, nloc, nx); b.st[0] = nloc; b.st[1] = nx; }
        const unsigned old = xb_add(&bar[XB_XSUB(b.x)], 1u);
        const unsigned gen = old / nloc;
        if (old + 1u == (gen + 1u) * nloc) {
            __builtin_amdgcn_fence(__ATOMIC_RELEASE, "agent");
            asm volatile("s_waitcnt vmcnt(0)" ::: "memory");
            const unsigned og = xb_add(&bar[XB_TOP], 1u);
            const unsigned tg = og / nx;
            if (og + 1u == (tg + 1u) * nx) xb_add(&bar[XB_TOPGEN], 1u);
            else XB_SPIN(xb_ld(&bar[XB_TOPGEN]) == tg, bar);
            __builtin_amdgcn_fence(__ATOMIC_ACQUIRE, "agent");
            xb_add(&bar[XB_XGEN(b.x)], 1u);
            asm volatile("s_waitcnt vmcnt(0)" ::: "memory");
        } else {
            XB_SPIN(xb_ld(&bar[XB_XGEN(b.x)]) == gen, bar);
            __builtin_amdgcn_fence(__ATOMIC_ACQUIRE, "agent");
            asm volatile("s_waitcnt vmcnt(0)" ::: "memory");
        }
    }
    __syncthreads();
}

constexpr int NWAVES = 8, NTHR = NWAVES * 64;
constexpr int D = 1024, NCTX_B = 16, SEQ = 256, DEPTH = 4, NLAT_B = 4, LSEQ = 2048, PAST = 512;
constexpr int NCTX = NCTX_B * SEQ, NLAT = NLAT_B * LSEQ, NTOK = NCTX + NLAT;
constexpr int GWID = 64, NH = 16, DH = 64, CK = 31, NMG = 5;
constexpr float EPS = 1e-6f;
constexpr float LOG2E_F = 1.4426950408889634f;

constexpr size_t MiB = 1u << 20;
constexpr size_t WS_CTL = 0, CTL_ZERO_BYTES = 64 * 1024;
constexpr size_t WS_MOD = 1 * MiB;
constexpr size_t WS_GS = WS_MOD + 256 * 1024;
constexpr size_t WS_BIAS = WS_MOD + 512 * 1024;
constexpr size_t WS_SSP = 2 * MiB;
constexpr size_t WS_WCI = 4 * MiB;
constexpr size_t WS_WCO = WS_WCI + 2 * (size_t)3072 * 1024 * 2;
constexpr size_t WS_WNI = WS_WCO + 2 * (size_t)1024 * 1024 * 2;
constexpr size_t WS_WNO = WS_WNI + 2 * (size_t)4096 * 1024 * 2;
constexpr size_t WS_CKB = 44 * MiB;
constexpr size_t WS_CVB = WS_CKB + (size_t)NLAT_B * 2 * PAST * D * 2;
constexpr size_t ACT_BYTES = (size_t)NTOK * D * 2;
constexpr size_t WS_XS = 64 * MiB, WS_G = 88 * MiB, WS_B0 = 112 * MiB, WS_B1 = 136 * MiB, WS_B2 = 160 * MiB, WS_B3 = 184 * MiB, WS_END = 208 * MiB;
static_assert(WS_WNO + 2 * (size_t)1024 * 1024 * 2 <= WS_CKB && WS_CVB + (size_t)NLAT_B * 2 * PAST * D * 2 <= WS_XS && ACT_BYTES <= 24 * MiB, "d_ws map");

constexpr int RING_OFF = 0, RING_BYTES = 131072;
constexpr int LDSCTL_OFF = RING_BYTES, MISC_OFF = LDSCTL_OFF + 320;
constexpr int LDS_BYTES = 147456;

struct Args {
    const float* in[19]; float* out; unsigned char* ws; int ph_lo, ph_hi;
};

struct Frame {
    LAS unsigned char* lds; volatile LAS unsigned* MISC; gu32* ctl;
    int tid, lane, wave, vcu, G;
};

__device__ __forceinline__ float wave_sum(float v) {
#pragma unroll
    for (int o = 1; o < 64; o <<= 1) v += __shfl_xor(v, o);
    return v;
}
__device__ __forceinline__ float bf2f(unsigned short b) { return __builtin_bit_cast(float, (unsigned)b << 16); }
__device__ __forceinline__ float bflo(unsigned w) { return __builtin_bit_cast(float, w << 16); }
__device__ __forceinline__ float bfhi(unsigned w) { return __builtin_bit_cast(float, w & 0xffff0000u); }
__device__ __forceinline__ float silu_f(float x) { return x * __builtin_amdgcn_rcpf(1.0f + __builtin_amdgcn_exp2f(-LOG2E_F * x)); }

__device__ __forceinline__ void transpose_item(const float* W, int K, int N, bf16* WT, int k0, int n0, int dst_row0, LAS float* scr, int lane) {
#pragma unroll 8
    for (int i = 0; i < 32; ++i) { const int kk = 2 * i + (lane >> 5); scr[kk * 33 + (lane & 31)] = W[(size_t)(k0 + kk) * N + n0 + (lane & 31)]; }
    LDS_WAIT(); asm volatile("" ::: "memory");
    const int c = lane & 7;
#pragma unroll
    for (int j = 0; j < 4; ++j) { const int n = (lane >> 3) + 8 * j; const LAS float* s = scr + (8 * c) * 33 + n;
        v4u o; o.x = pk2(s[0 * 33], s[1 * 33]); o.y = pk2(s[2 * 33], s[3 * 33]); o.z = pk2(s[4 * 33], s[5 * 33]); o.w = pk2(s[6 * 33], s[7 * 33]);
        *(GAS v4u*)(WT + (size_t)(dst_row0 + n) * K + k0 + 8 * c) = o; }
    LDS_WAIT(); asm volatile("" ::: "memory");
}
__device__ __forceinline__ int conv_in_row(int n) { return n < 1024 ? ((n >> 7) * 256 + (n & 127)) : (n < 2048 ? (((n - 1024) >> 7) * 256 + 128 + (n & 127)) : n); }

__device__ __forceinline__ void phase_p0a(Frame& F, const Args& a) {
    const float* c = a.in[2]; const float* cache_k = a.in[3]; const float* cache_v = a.in[4]; const float* c_ctx = a.in[5];
    const float* ada_w = a.in[7]; const float* ada_b = a.in[8];
    float* mod = (float*)(a.ws + WS_MOD);
    {
        LAS float* sc = (LAS float*)(F.lds);
        LAS float* red = (LAS float*)(F.lds + 20480);
        for (int i = F.tid; i < NMG * D; i += NTHR) { const int v = i >> 10, k = i & 1023; const float x = v == 0 ? c_ctx[k] : c[(v - 1) * D + k]; sc[i] = silu_f(x); }
        __syncthreads();
        for (int it = blockIdx.x; it < DEPTH * 48; it += F.G) {
            const int layer = it / 48, n0 = (it % 48) * 64;
            const float* w = ada_w + (size_t)layer * D * 3 * D + n0 + F.lane;
            float acc[NMG] = {0.f, 0.f, 0.f, 0.f, 0.f};
            const int kb = F.wave * 128;
#pragma unroll 8
            for (int k = 0; k < 128; ++k) { const float wv = w[(size_t)(kb + k) * 3 * D];
#pragma unroll
                for (int v = 0; v < NMG; ++v) acc[v] += sc[v * D + kb + k] * wv; }
#pragma unroll
            for (int v = 0; v < NMG; ++v) red[(F.wave * NMG + v) * 64 + F.lane] = acc[v];
            __syncthreads();
            if (F.tid < NMG * 64) { const int v = F.tid >> 6, l = F.tid & 63; float s = 0.f;
#pragma unroll
                for (int w8 = 0; w8 < 8; ++w8) s += red[(w8 * NMG + v) * 64 + l];
                mod[((size_t)v * DEPTH + layer) * 3 * D + n0 + l] = s + ada_b[layer * 3 * D + n0 + l]; }
            __syncthreads();
        }
        __syncthreads();
    }
    {
        LAS float* scr = (LAS float*)(F.lds + F.wave * 16384);
        const int gw = F.vcu * NWAVES + F.wave, NGW = F.G * NWAVES;
        constexpr int I_CI = 16 * 96, I_CO = 16 * 32, I_NI = 16 * 128, I_NO = 16 * 32;
        constexpr int NITEMS = 2 * (I_CI + I_CO + I_NI + I_NO);
        for (int it = gw; it < NITEMS; it += NGW) {
            int r = it;
            if (r < 2 * I_CI) { const int j = r / I_CI; r %= I_CI; const int kb = r / 96, nb = r % 96;
                transpose_item(a.in[9] + (size_t)j * D * 3072, D, 3072, (bf16*)(a.ws + WS_WCI) + (size_t)j * 3072 * D, kb * 64, nb * 32, conv_in_row(nb * 32), scr, F.lane); continue; }
            r -= 2 * I_CI;
            if (r < 2 * I_CO) { const int j = r / I_CO; r %= I_CO; const int kb = r / 32, nb = r % 32;
                transpose_item(a.in[14] + (size_t)j * D * D, D, D, (bf16*)(a.ws + WS_WCO) + (size_t)j * D * D, kb * 64, nb * 32, nb * 32, scr, F.lane); continue; }
            r -= 2 * I_CO;
            if (r < 2 * I_NI) { const int j = r / I_NI; r %= I_NI; const int kb = r / 128, nb = r % 128;
                transpose_item(a.in[15] + (size_t)j * D * 4096, D, 4096, (bf16*)(a.ws + WS_WNI) + (size_t)j * 4096 * D, kb * 64, nb * 32, nb * 32, scr, F.lane); continue; }
            r -= 2 * I_NI;
            { const int j = r / I_NO; r %= I_NO; const int kb = r / 32, nb = r % 32;
                transpose_item(a.in[17] + (size_t)j * D * D, D, D, (bf16*)(a.ws + WS_WNO) + (size_t)j * D * D, kb * 64, nb * 32, nb * 32, scr, F.lane); }
        }
        constexpr int CITEMS = NLAT_B * 2 * PAST * D / 512;
        for (int it = gw; it < 2 * CITEMS; it += NGW) {
            const bool isv = it >= CITEMS; const int r = isv ? it - CITEMS : it;
            const float* src = (isv ? cache_v : cache_k) + (size_t)r * 512 + F.lane * 8;
            bf16* dst = (bf16*)(a.ws + (isv ? WS_CVB : WS_CKB)) + (size_t)r * 512 + F.lane * 8;
            const f32x4 x0 = *(const f32x4*)src, x1 = *(const f32x4*)(src + 4);
            v4u o; o.x = pk2(x0[0], x0[1]); o.y = pk2(x0[2], x0[3]); o.z = pk2(x1[0], x1[1]); o.w = pk2(x1[2], x1[3]);
            *(v4u*)dst = o;
        }
    }
}

__device__ __forceinline__ void phase_p0b(Frame& F, const Args& a) {
    const float* mod = (const float*)(a.ws + WS_MOD); const float* norm_g = a.in[6];
    float* GS = (float*)(a.ws + WS_GS); float* BIAS = (float*)(a.ws + WS_BIAS); float* ssp = (float*)(a.ws + WS_SSP);
    bf16* XS = (bf16*)(a.ws + WS_XS);
    const int gw = F.vcu * NWAVES + F.wave, NGW = F.G * NWAVES;
    for (int i = (blockIdx.x * NTHR + F.tid); i < DEPTH * NMG * D; i += F.G * NTHR) { const int layer = i / (NMG * D), mg = (i / D) % NMG, k = i % D;
        GS[i] = norm_g[layer * D + k] * (1.0f + mod[((size_t)mg * DEPTH + layer) * 3 * D + D + k]); }
    for (int t = gw; t < NTOK; t += NGW) {
        const float* xr = t < NCTX ? a.in[0] + (size_t)t * D : a.in[1] + (size_t)(t - NCTX) * D;
        const int mg = t < NCTX ? 0 : 1 + (t - NCTX) / LSEQ;
        const float* sc = mod + ((size_t)mg * DEPTH + 0) * 3 * D + D; const float* ng = norm_g;
        float s = 0.f;
#pragma unroll
        for (int jj = 0; jj < 4; ++jj) { const int k = jj * 256 + F.lane * 4; const f32x4 v = *(const f32x4*)(xr + k); const f32x4 g4 = *(const f32x4*)(ng + k); const f32x4 s4 = *(const f32x4*)(sc + k);
            s += (v[0] * v[0] + v[1] * v[1]) + (v[2] * v[2] + v[3] * v[3]);
            const f32x4 o = v * g4 * (s4 + 1.0f);
            unsigned long long w = (unsigned long long)pk2(o[0], o[1]) | ((unsigned long long)pk2(o[2], o[3]) << 32);
            *(unsigned long long*)(XS + (size_t)t * D + k) = w; }
        s = wave_sum(s);
        if (F.lane < 16) ssp[(size_t)t * 16 + F.lane] = F.lane == 0 ? s : 0.f;
    }
    {
        LAS float* sh = (LAS float*)F.lds;
        int cur_layer = -1;
        for (int it = blockIdx.x; it < 224; it += F.G) {
            int layer, chunk; if (it < 48) { layer = 0; chunk = it; } else if (it < 112) { layer = 1; chunk = it - 48; } else if (it < 160) { layer = 2; chunk = it - 112; } else { layer = 3; chunk = it - 160; }
            if (layer != cur_layer) { __syncthreads();
                for (int i = F.tid; i < NMG * D; i += NTHR) sh[i] = mod[((size_t)(i >> 10) * DEPTH + layer) * 3 * D + (i & 1023)];
                cur_layer = layer; __syncthreads(); }
            const bf16* WT = (layer & 1) ? (const bf16*)(a.ws + WS_WNI) + (size_t)(layer >> 1) * 4096 * D : (const bf16*)(a.ws + WS_WCI) + (size_t)(layer >> 1) * 3072 * D;
            for (int rr = 0; rr < 8; ++rr) { const int n = chunk * 64 + F.wave * 8 + rr;
                const v4u w0 = *(const v4u*)(WT + (size_t)n * D + F.lane * 16), w1 = *(const v4u*)(WT + (size_t)n * D + F.lane * 16 + 8);
                float wf[16] = {bflo(w0.x), bfhi(w0.x), bflo(w0.y), bfhi(w0.y), bflo(w0.z), bfhi(w0.z), bflo(w0.w), bfhi(w0.w),
                                bflo(w1.x), bfhi(w1.x), bflo(w1.y), bfhi(w1.y), bflo(w1.z), bfhi(w1.z), bflo(w1.w), bfhi(w1.w)};
#pragma unroll
                for (int v = 0; v < NMG; ++v) { float s = 0.f;
#pragma unroll
                    for (int q = 0; q < 16; ++q) s += wf[q] * sh[v * D + F.lane * 16 + q];
                    s = wave_sum(s);
                    if (F.lane == 0) BIAS[((size_t)layer * NMG + v) * 4096 + n] = s; } }
        }
    }
}

__device__ __forceinline__ void phase_final(Frame& F, const Args& a) {
    const float* ssp = (const float*)(a.ws + WS_SSP); const float* fg = a.in[18];
    const int gw = F.vcu * NWAVES + F.wave, NGW = F.G * NWAVES;
    for (int t = gw; t < NTOK; t += NGW) {
        const float rs = pg8::row_rscale(ssp, t);
        float* xr = a.out + (size_t)t * D;
#pragma unroll
        for (int jj = 0; jj < 4; ++jj) { const int k = jj * 256 + F.lane * 4; f32x4 v = *(const f32x4*)(xr + k); const f32x4 g4 = *(const f32x4*)(fg + k);
            *(f32x4*)(xr + k) = v * rs * g4; }
    }
}

constexpr int N_PHASES = 15;
__global__ void __launch_bounds__(NTHR, 2) mk_fwd(Args args) {
    extern __shared__ __attribute__((aligned(16))) unsigned char lds[];
    Frame F;
    F.lds = (LAS unsigned char*)lds;
    F.MISC = (volatile LAS unsigned*)(F.lds + MISC_OFF);
    F.tid = threadIdx.x; asm volatile("" : "+v"(F.tid)); F.lane = F.tid & 63; F.wave = __builtin_amdgcn_readfirstlane(F.tid >> 6);
    F.G = gridDim.x; { const int bx = blockIdx.x; F.vcu = (F.G % 8 == 0) ? (bx % 8) * (F.G / 8) + bx / 8 : bx; }
    unsigned char* ws = args.ws;
    F.ctl = (gu32*)(ws + WS_CTL);
    const int lo = args.ph_lo, hi = args.ph_hi;
#define IN(k) (lo <= (k) && (k) < hi)
    if (IN(0)) phase_p0a(F, args);
    if (IN(1)) phase_p0b(F, args);
    bf16* XS = (bf16*)(ws + WS_XS); bf16* G = (bf16*)(ws + WS_G); bf16* B0 = (bf16*)(ws + WS_B0); bf16* B1 = (bf16*)(ws + WS_B1); bf16* B2 = (bf16*)(ws + WS_B2); bf16* B3 = (bf16*)(ws + WS_B3);
    float* ssp = (float*)(ws + WS_SSP); const float* mod = (const float*)(ws + WS_MOD);
    float* x = args.out; float* newk = args.out + (size_t)NTOK * D; float* newv = newk + (size_t)NCTX_B * 2 * SEQ * D;
#pragma unroll 1
    for (int layer = 0; layer < DEPTH; ++layer) {
        const int j = layer >> 1;
        const float* bias = (const float*)(ws + WS_BIAS) + (size_t)layer * NMG * 4096;
        if (IN(2 + 3 * layer)) {
            if ((layer & 1) == 0) {
                pg8::Gemm g{XS, (const bf16*)(ws + WS_WCI) + (size_t)j * 3072 * D, NTOK, 3072, D}; pg8::StaticOrder S; S.init(NTOK, 3072, F.G, (int)blockIdx.x);
                pg8::EpiConv1 E{ssp, bias, B0, B1};
                pg8::gemm_phase<pg8::EpiConv1, pg8::StaticOrder, true, true>(F.lds + RING_OFF, g, S, E);
            } else {
                pg8::Gemm g{XS, (const bf16*)(ws + WS_WNI) + (size_t)j * 4096 * D, NTOK, 4096, D}; pg8::StaticOrder S; S.init(NTOK, 4096, F.G, (int)blockIdx.x);
                pg8::EpiAttn1 E{ssp, bias, B0, (size_t)(WS_B1 - WS_B0) / 2, newk, (size_t)NCTX_B * 2 * SEQ * D, j};
                pg8::gemm_phase<pg8::EpiAttn1, pg8::StaticOrder, true, true>(F.lds + RING_OFF, g, S, E);
            }
        }
        if (IN(4 + 3 * layer)) {
            const bf16* WT = (layer & 1) ? (const bf16*)(ws + WS_WNO) + (size_t)j * D * D : (const bf16*)(ws + WS_WCO) + (size_t)j * D * D;
            pg8::Gemm g{G, WT, NTOK, D, D}; pg8::StaticOrder S; S.init(NTOK, D, F.G, (int)blockIdx.x);
            const float* bc = layer == 0 ? args.in[0] : x; const float* bl = layer == 0 ? args.in[1] : x + (size_t)NCTX * D;
            const float* gate = mod + (size_t)layer * 3 * D + 2 * D;
            if (layer < DEPTH - 1) {
                pg8::EpiGemm2<true> E{bc, bl, x, gate, DEPTH * 3 * D, (const float*)(ws + WS_GS) + (size_t)(layer + 1) * NMG * D, XS, ssp};
                pg8::gemm_phase<pg8::EpiGemm2<true>, pg8::StaticOrder, true, true>(F.lds + RING_OFF, g, S, E);
            } else {
                pg8::EpiGemm2<false> E{bc, bl, x, gate, DEPTH * 3 * D, nullptr, XS, ssp};
                pg8::gemm_phase<pg8::EpiGemm2<false>, pg8::StaticOrder, true, true>(F.lds + RING_OFF, g, S, E);
            }
        }
    }
    if (IN(14)) phase_final(F, args);
#undef IN
}

__global__ void __launch_bounds__(256) k_conv_b(const bf16* __restrict__ U, const bf16* __restrict__ SZ, const float* __restrict__ dw_w, const float* __restrict__ dw_b,
                                                 const float* __restrict__ ln_g, const float* __restrict__ ln_b, bf16* __restrict__ Gb) {
    const int t = blockIdx.x;
    int s0, len;
    if (t < NCTX) { s0 = (t / SEQ) * SEQ; len = SEQ; } else { s0 = NCTX + ((t - NCTX) / LSEQ) * LSEQ; len = LSEQ; }
    const int l = t - s0;
    float v[4]; float s = 0.f;
#pragma unroll
    for (int i = 0; i < 4; ++i) {
        int c = threadIdx.x + i * 256;
        float acc = dw_b[c];
        for (int k = 0; k < CK; ++k) { int ll = l + k - CK / 2; if (ll >= 0 && ll < len) acc += bf2f(U[(size_t)(s0 + ll) * D + c]) * dw_w[k * D + c]; }
        v[i] = acc; s += acc;
    }
    __shared__ float red[256];
    red[threadIdx.x] = s; __syncthreads();
    for (int o = 128; o > 0; o >>= 1) { if (threadIdx.x < o) red[threadIdx.x] += red[threadIdx.x + o]; __syncthreads(); }
    const float mu = red[0] / D; __syncthreads();
    float q = 0.f;
#pragma unroll
    for (int i = 0; i < 4; ++i) { float d = v[i] - mu; q += d * d; }
    red[threadIdx.x] = q; __syncthreads();
    for (int o = 128; o > 0; o >>= 1) { if (threadIdx.x < o) red[threadIdx.x] += red[threadIdx.x + o]; __syncthreads(); }
    const float rstd = rsqrtf(red[0] / D + EPS);
#pragma unroll
    for (int i = 0; i < 4; ++i) { int c = threadIdx.x + i * 256; float u = (v[i] - mu) * rstd * ln_g[c] + ln_b[c];
        Gb[(size_t)t * D + c] = (bf16)f2bf(silu_f(u) * bf2f(SZ[(size_t)t * D + c])); }
}

__global__ void __launch_bounds__(256) k_ctx_attn_b(const bf16* __restrict__ Q, const bf16* __restrict__ K, const bf16* __restrict__ V, const bf16* __restrict__ SZ, bf16* __restrict__ Gb) {
    const int t = blockIdx.x, h = blockIdx.y, b = t / SEQ;
    __shared__ float sq[DH]; __shared__ float sp[SEQ]; __shared__ float red[256];
    if (threadIdx.x < DH) sq[threadIdx.x] = bf2f(Q[(size_t)t * D + h * DH + threadIdx.x]);
    __syncthreads();
    const int l = threadIdx.x;
    const bf16* kr = K + (size_t)(b * SEQ + l) * D + h * DH;
    float sc = 0.f;
    for (int d = 0; d < DH; ++d) sc += sq[d] * bf2f(kr[d]);
    red[threadIdx.x] = sc; __syncthreads();
    for (int o = 128; o > 0; o >>= 1) { if (threadIdx.x < o) red[threadIdx.x] = fmaxf(red[threadIdx.x], red[threadIdx.x + o]); __syncthreads(); }
    const float mx = red[0]; __syncthreads();
    const float p = exp2f(sc - mx);
    sp[l] = p; red[threadIdx.x] = p; __syncthreads();
    for (int o = 128; o > 0; o >>= 1) { if (threadIdx.x < o) red[threadIdx.x] += red[threadIdx.x + o]; __syncthreads(); }
    const float inv = 1.f / red[0];
    if (threadIdx.x < DH) { const int d = threadIdx.x; float o = 0.f;
        for (int ll = 0; ll < SEQ; ++ll) o += sp[ll] * bf2f(V[(size_t)(b * SEQ + ll) * D + h * DH + d]);
        const size_t idx = (size_t)t * D + h * DH + d;
        Gb[idx] = (bf16)f2bf(o * inv * bf2f(SZ[idx])); }
}

__global__ void __launch_bounds__(256) k_na_attn_b(const bf16* __restrict__ Q, const bf16* __restrict__ K, const bf16* __restrict__ V, const bf16* __restrict__ SZ,
                                                    const bf16* __restrict__ CKb, const bf16* __restrict__ CVb, const float* __restrict__ rpb, int j, bf16* __restrict__ Gb) {
    const int tl = blockIdx.x, h = blockIdx.y;
    const int b = tl / LSEQ, n = tl % LSEQ, r = n / GWID, c = n % GWID;
    const int t = NCTX + tl;
    __shared__ float sq[DH]; __shared__ float sp[128 + PAST]; __shared__ float red[256];
    if (threadIdx.x < DH) sq[threadIdx.x] = bf2f(Q[(size_t)t * D + h * DH + threadIdx.x]);
    __syncthreads();
    int rs = r - 4; rs = rs < 0 ? 0 : (rs > 24 ? 24 : rs);
    int qs = c - 8; qs = qs < 0 ? 0 : (qs > 48 ? 48 : qs);
    const bf16* ck = CKb + ((size_t)(b * 2 + j) * PAST) * D + h * DH;
    const bf16* cv = CVb + ((size_t)(b * 2 + j) * PAST) * D + h * DH;
    const float* rp = rpb + ((size_t)j * NH + h) * 15 * 31;
    float mx = -3.0e38f;
    for (int i = threadIdx.x; i < 128 + PAST; i += 256) {
        float sc = 0.f;
        if (i < 128) { int rr = rs + i / 16, kc = qs + i % 16;
            const bf16* kr = K + (size_t)(NCTX + b * LSEQ + rr * GWID + kc) * D + h * DH;
            for (int d = 0; d < DH; ++d) sc += sq[d] * bf2f(kr[d]);
            int dr = rr - r + 7, dc = kc - c + 15; dc = dc < 0 ? 0 : (dc > 30 ? 30 : dc);
            sc += rp[dr * 31 + dc] * LOG2E_F;
        } else { const bf16* kr = ck + (size_t)(i - 128) * D; for (int d = 0; d < DH; ++d) sc += sq[d] * bf2f(kr[d]); }
        sp[i] = sc; mx = fmaxf(mx, sc);
    }
    red[threadIdx.x] = mx; __syncthreads();
    for (int o = 128; o > 0; o >>= 1) { if (threadIdx.x < o) red[threadIdx.x] = fmaxf(red[threadIdx.x], red[threadIdx.x + o]); __syncthreads(); }
    mx = red[0]; __syncthreads();
    float ps = 0.f;
    for (int i = threadIdx.x; i < 128 + PAST; i += 256) { float p = exp2f(sp[i] - mx); sp[i] = p; ps += p; }
    red[threadIdx.x] = ps; __syncthreads();
    for (int o = 128; o > 0; o >>= 1) { if (threadIdx.x < o) red[threadIdx.x] += red[threadIdx.x + o]; __syncthreads(); }
    const float inv = 1.f / red[0];
    if (threadIdx.x < DH) { const int d = threadIdx.x; float o = 0.f;
        for (int i = 0; i < 128; ++i) { int rr = rs + i / 16, kc = qs + i % 16; o += sp[i] * bf2f(V[(size_t)(NCTX + b * LSEQ + rr * GWID + kc) * D + h * DH + d]); }
        for (int i = 0; i < PAST; ++i) o += sp[128 + i] * bf2f(cv[(size_t)i * D + d]);
        const size_t idx = (size_t)t * D + h * DH + d;
        Gb[idx] = (bf16)f2bf(o * inv * bf2f(SZ[idx])); }
}

extern "C" void kernel_launch(void* const* d_in, const int* in_sizes, int n_in, void* d_out, int out_size, void* d_ws, size_t ws_size, hipStream_t stream) {
    static int grid = 0;
    if (grid == 0) {
        int dev = 0, cus = 0, per_cu = 0;
        if (n_in != 19 || ws_size < WS_END) { fprintf(stderr, "kernel_launch: unexpected n_in %d / ws %zu\n", n_in, ws_size); grid = -1; return; }
        if (hipGetDevice(&dev) != hipSuccess || hipDeviceGetAttribute(&cus, hipDeviceAttributeMultiprocessorCount, dev) != hipSuccess) { grid = -1; return; }
        if (hipFuncSetAttribute((const void*)mk_fwd, hipFuncAttributeMaxDynamicSharedMemorySize, LDS_BYTES) != hipSuccess) { fprintf(stderr, "kernel_launch: hipFuncSetAttribute failed\n"); grid = -1; return; }
        if (hipOccupancyMaxActiveBlocksPerMultiprocessor(&per_cu, (const void*)mk_fwd, NTHR, LDS_BYTES) != hipSuccess || per_cu < 1) { fprintf(stderr, "kernel_launch: occupancy query says %d\n", per_cu); }
        (void)hipGetLastError();
        grid = cus;
    }
    if (grid < 0) return;
    (void)hipMemsetAsync((char*)d_ws + WS_CTL, 0, CTL_ZERO_BYTES, stream);
    Args a{};
    for (int i = 0; i < 19; ++i) a.in[i] = (const float*)d_in[i];
    a.out = (float*)d_out; a.ws = (unsigned char*)d_ws;
    unsigned char* ws = (unsigned char*)d_ws;
    bf16* G = (bf16*)(ws + WS_G); bf16* B0 = (bf16*)(ws + WS_B0); bf16* B1 = (bf16*)(ws + WS_B1); bf16* B2 = (bf16*)(ws + WS_B2); bf16* B3 = (bf16*)(ws + WS_B3);
    auto run = [&](int lo, int hi) { a.ph_lo = lo; a.ph_hi = hi; hipLaunchKernelGGL(mk_fwd, dim3(grid), dim3(NTHR), LDS_BYTES, stream, a); };
    run(0, 1); run(1, 2);
    for (int layer = 0; layer < DEPTH; ++layer) {
        const int j = layer >> 1;
        run(2 + 3 * layer, 3 + 3 * layer);
        if ((layer & 1) == 0) {
            k_conv_b<<<NTOK, 256, 0, stream>>>(B0, B1, a.in[10] + (size_t)j * CK * D, a.in[11] + j * D, a.in[12] + j * D, a.in[13] + j * D, G);
        } else {
            k_ctx_attn_b<<<dim3(NCTX, NH), 256, 0, stream>>>(B0, B2, B3, B1, G);
            k_na_attn_b<<<dim3(NLAT, NH), 256, 0, stream>>>(B0, B2, B3, B1, (const bf16*)(ws + WS_CKB), (const bf16*)(ws + WS_CVB), a.in[16], j, G);
        }
        run(4 + 3 * layer, 5 + 3 * layer);
    }
    run(14, 15);
}
```

```cpp
#include <hip/hip_runtime.h>
#include <cstdio>
#include <cstdint>
namespace pg8 {
#define PG8_LAS __attribute__((address_space(3)))
typedef unsigned short bf16_t;
typedef short bf16x8 __attribute__((ext_vector_type(8)));
typedef float f32x4 __attribute__((ext_vector_type(4)));
typedef unsigned u32x4 __attribute__((ext_vector_type(4)));
constexpr int BM = 256, BK = 64, HALF = 128, HTB = HALF * BK * 2  , STAGE_BYTES = 8 * HTB, NXCD = 8, WGM = 8;

__host__ __device__ __forceinline__ int lds_byte(int r, int c) { const int st = (r >> 4) * 2 + (c >> 5), rr = r & 15, cc = c & 31, ob = rr * 64 + cc * 2; return st * 1024 + (ob ^ (((ob >> 9) & 1) << 5)); }
__host__ __device__ __forceinline__ void stage_rc(int b, int& R, int& C) { const int st = b / 1024, sb = b % 1024, swz = sb ^ (((sb >> 9) & 1) << 5); R = (st >> 1) * 16 + swz / 64; C = (st & 1) * 32 + (swz % 64) / 2; }
__host__ __device__ __forceinline__ int perm32(int rho) { const int n = rho >> 4, i = rho & 15; return 8 * (i >> 2) + 4 * n + (i & 3); }

struct Unit { int pm, pn; };
struct Gemm { const bf16_t* A; const bf16_t* Bt; int M, N, K; };

struct StaticOrder {
    int nM, nN, nwg, G, c;
    __host__ __device__ void init(int M, int N, int G_, int c_) { nM = M / BM; nN = N / BM; nwg = nM * nN; G = G_; c = c_; }
    __host__ __device__ bool next(int i, Unit& u) const {
        const long L = (long)i * G + c; if (L >= nwg) return false;
        int wgid = (int)L; { const int q = nwg / NXCD, r = nwg % NXCD, xcd = wgid % NXCD, off = wgid / NXCD; wgid = (xcd < r ? xcd * (q + 1) : r * (q + 1) + (xcd - r) * q) + off; }
        const int nig = WGM * nN, gid = wgid / nig, fm = gid * WGM, gsz = (nM - fm) < WGM ? (nM - fm) : WGM;
        u.pm = fm + ((wgid % nig) % gsz); u.pn = (wgid % nig) / gsz; return true;
    }
    __device__ __forceinline__ void a_ready(const Unit&) const {}
    __device__ __forceinline__ void done(const Unit&) const {}
};


__device__ __forceinline__ unsigned cvt_pk_bf16(float lo, float hi) { unsigned r; asm volatile("v_cvt_pk_bf16_f32 %0, %1, %2" : "=v"(r) : "v"(lo), "v"(hi)); return r; }
constexpr int ROWLEN = 1024;
constexpr int NTOKC = 4096;
constexpr float RMS_EPS = 1e-6f;
constexpr float LOG2E = 1.4426950408889634f;
constexpr float QSCALE = 0.125f * LOG2E;
__device__ __forceinline__ int mg_of_tile(int pm) { return pm < 16 ? 0 : 1 + ((pm - 16) >> 3); }
__device__ __forceinline__ float fast_sigmoid(float x) { return __builtin_amdgcn_rcpf(1.0f + __builtin_amdgcn_exp2f(-LOG2E * x)); }
__device__ __forceinline__ f32x4 sigm4(f32x4 v) { return (f32x4){fast_sigmoid(v[0]), fast_sigmoid(v[1]), fast_sigmoid(v[2]), fast_sigmoid(v[3])}; }
__device__ __forceinline__ u32x4 pack8(f32x4 a, f32x4 b) { u32x4 w; w.x = cvt_pk_bf16(a[0], a[1]); w.y = cvt_pk_bf16(a[2], a[3]); w.z = cvt_pk_bf16(b[0], b[1]); w.w = cvt_pk_bf16(b[2], b[3]); return w; }
__device__ __forceinline__ float row_rscale(const float* ssp, int row) {
    const f32x4* p = (const f32x4*)(ssp + (size_t)row * 16);
    const f32x4 a = p[0], b = p[1], c = p[2], d = p[3];
    const f32x4 s = (a + b) + (c + d);
    return __builtin_amdgcn_rsqf(((s[0] + s[1]) + (s[2] + s[3])) * (1.0f / ROWLEN) + RMS_EPS);
}

struct EpiConv1 {
    static constexpr bool PERM = true, AFTER_DRAIN = false;
    const float* ssp; const float* bias  ; bf16_t* U; bf16_t* SZ;
    __device__ __forceinline__ void operator()(const f32x4 (&acc)[2][2][4][2], const Unit& u, int wr, int wc, int fr, int fq) const {
        const int mg = mg_of_tile(u.pm);
        const float* bb = bias + mg * 4096 + u.pn * BM + wc * 32 + 8 * fq;
        f32x4 bv[2][2];
#pragma unroll
        for (int bj = 0; bj < 2; ++bj)
#pragma unroll
            for (int n = 0; n < 2; ++n) bv[bj][n] = *(const f32x4*)(bb + bj * HALF + 4 * n);
        const int row0 = u.pm * BM + wr * 64 + fr;
        if (u.pn < 8) {
            const int col = u.pn * HALF + wc * 32 + 8 * fq;
#pragma unroll
            for (int ai = 0; ai < 2; ++ai)
#pragma unroll
                for (int m = 0; m < 4; ++m) { const int row = row0 + ai * HALF + m * 16; const float rs = row_rscale(ssp, row);
                    const f32x4 a0 = acc[ai][0][m][0] * rs + bv[0][0], a1 = acc[ai][0][m][1] * rs + bv[0][1];
                    const f32x4 b0 = acc[ai][1][m][0] * rs + bv[1][0], b1 = acc[ai][1][m][1] * rs + bv[1][1];
                    *(u32x4*)(U + (size_t)row * ROWLEN + col) = pack8(a0 * sigm4(b0), a1 * sigm4(b1)); }
        } else {
            const int col = (u.pn - 8) * BM + wc * 32 + 8 * fq;
#pragma unroll
            for (int ai = 0; ai < 2; ++ai)
#pragma unroll
                for (int m = 0; m < 4; ++m) { const int row = row0 + ai * HALF + m * 16; const float rs = row_rscale(ssp, row);
#pragma unroll
                    for (int bj = 0; bj < 2; ++bj) { const f32x4 z0 = acc[ai][bj][m][0] * rs + bv[bj][0], z1 = acc[ai][bj][m][1] * rs + bv[bj][1];
                        *(u32x4*)(SZ + (size_t)row * ROWLEN + col + bj * HALF) = pack8(z0 * sigm4(z0), z1 * sigm4(z1)); } }
        }
    }
};

struct EpiAttn1 {
    static constexpr bool PERM = true, AFTER_DRAIN = false;
    const float* ssp; const float* bias; bf16_t* B0; size_t bstride  ; float* newk; size_t nstride  ; int j;
    __device__ __forceinline__ void operator()(const f32x4 (&acc)[2][2][4][2], const Unit& u, int wr, int wc, int fr, int fq) const {
        const int mg = mg_of_tile(u.pm);
        const float* bb = bias + mg * 4096 + u.pn * BM + wc * 32 + 8 * fq;
        f32x4 bv[2][2];
#pragma unroll
        for (int bj = 0; bj < 2; ++bj)
#pragma unroll
            for (int n = 0; n < 2; ++n) bv[bj][n] = *(const f32x4*)(bb + bj * HALF + 4 * n);
        const int row0 = u.pm * BM + wr * 64 + fr;
        const int sect = u.pn >> 2, col = (u.pn & 3) * BM + wc * 32 + 8 * fq;
        const int bidx = sect == 0 ? 0 : (sect == 3 ? 1 : sect + 1);
        bf16_t* dst = B0 + (size_t)bidx * bstride;
        float* cdst = newk + (sect == 2 ? nstride : (size_t)0);
        const bool cache = (sect == 1 || sect == 2) && u.pm < 16;
        const float qs = sect == 0 ? QSCALE : 1.0f;
#pragma unroll
        for (int ai = 0; ai < 2; ++ai)
#pragma unroll
            for (int m = 0; m < 4; ++m) { const int row = row0 + ai * HALF + m * 16; const float rs = row_rscale(ssp, row);
#pragma unroll
                for (int bj = 0; bj < 2; ++bj) { f32x4 v0 = acc[ai][bj][m][0] * rs + bv[bj][0], v1 = acc[ai][bj][m][1] * rs + bv[bj][1];
                    if (cache) { float* cp = cdst + ((size_t)(u.pm * 2 + j) * 256 + (row - u.pm * BM)) * ROWLEN + col + bj * HALF; *(f32x4*)cp = v0; *(f32x4*)(cp + 4) = v1; }
                    v0 = v0 * qs; v1 = v1 * qs;
                    if (sect == 3) { v0 = v0 * sigm4(v0); v1 = v1 * sigm4(v1); }
                    *(u32x4*)(dst + (size_t)row * ROWLEN + col + bj * HALF) = pack8(v0, v1); } }
    }
};

template <bool HAS_NEXT> struct EpiGemm2 {
    static constexpr bool PERM = true, AFTER_DRAIN = false;
    const float* base_ctx; const float* base_lat; float* out; const float* gate  ; int gate_stride; const float* gsn  ; bf16_t* XS; float* ssp;
    __device__ __forceinline__ void operator()(const f32x4 (&acc)[2][2][4][2], const Unit& u, int wr, int wc, int fr, int fq) const {
        const int mg = mg_of_tile(u.pm);
        const int col = u.pn * BM + wc * 32 + 8 * fq;
        f32x4 gv[2][2], sv[2][2];
#pragma unroll
        for (int bj = 0; bj < 2; ++bj)
#pragma unroll
            for (int n = 0; n < 2; ++n) { gv[bj][n] = *(const f32x4*)(gate + (size_t)mg * gate_stride + col + bj * HALF + 4 * n);
                if (HAS_NEXT) sv[bj][n] = *(const f32x4*)(gsn + mg * ROWLEN + col + bj * HALF + 4 * n); }
        const int row0 = u.pm * BM + wr * 64 + fr;
        const float* base = u.pm < 16 ? base_ctx : base_lat - (size_t)NTOKC * ROWLEN;
#pragma unroll
        for (int ai = 0; ai < 2; ++ai)
#pragma unroll
            for (int m = 0; m < 4; ++m) { const int row = row0 + ai * HALF + m * 16; float sq = 0.f;
#pragma unroll
                for (int bj = 0; bj < 2; ++bj) { const size_t off = (size_t)row * ROWLEN + col + bj * HALF;
                    const f32x4 x0 = *(const f32x4*)(base + off) + gv[bj][0] * acc[ai][bj][m][0], x1 = *(const f32x4*)(base + off + 4) + gv[bj][1] * acc[ai][bj][m][1];
                    *(f32x4*)(out + off) = x0; *(f32x4*)(out + off + 4) = x1;
                    sq += (x0[0] * x0[0] + x0[1] * x0[1]) + (x0[2] * x0[2] + x0[3] * x0[3]) + (x1[0] * x1[0] + x1[1] * x1[1]) + (x1[2] * x1[2] + x1[3] * x1[3]);
                    if (HAS_NEXT) *(u32x4*)(XS + off) = pack8(x0 * sv[bj][0], x1 * sv[bj][1]); }
                sq += __shfl_xor(sq, 16); sq += __shfl_xor(sq, 32);
                if (fq == 0) ssp[(size_t)row * 16 + u.pn * 4 + wc] = sq; }
    }
};
template <class Epi, class Sched, bool ALIGN_EPI = false, bool SP2 = false>
__device__ __forceinline__ void gemm_phase(PG8_LAS unsigned char* lds, const Gemm g, const Sched& S, const Epi& E) {
    int tid_ = threadIdx.x; asm volatile("" : "+v"(tid_));
    const int tid = tid_, wid = __builtin_amdgcn_readfirstlane(tid >> 6), lane = tid & 63, wr = wid >> 2, wc = wid & 3, fr = lane & 15, fq = lane >> 4;
    const int K = g.K, nt = K / BK;
    unsigned voffA[2], voffB[2];
#pragma unroll
    for (int i = 0; i < 2; ++i) { int R, C; stage_rc(tid * 16 + i * 8192, R, C); const int Rb = Epi::PERM ? ((R & ~31) + perm32(R & 31)) : R;
        voffA[i] = (unsigned)(R * K + C) * 2u; voffB[i] = (unsigned)(Rb * K + C) * 2u; }
    const size_t kstep = (size_t)(BK * 2);
    const size_t hstep = (size_t)HALF * K * 2;
    const size_t tstep = 2 * hstep;
    const unsigned ldsw = (unsigned)wid * 1024u;
    const int aoff = lds_byte(wr * 64 + fr, fq * 8), boff = lds_byte(wc * 32 + fr, fq * 8);
#define PG8_SA(b, h) (((b) * 2 + (h)) * HTB)
#define PG8_SB(b, h) ((4 + (b) * 2 + (h)) * HTB)
#define PG8_STAGE(bufoff, gbase, voff) do { _Pragma("unroll") for (int _i = 0; _i < 2; ++_i) \
        __builtin_amdgcn_global_load_lds((const unsigned*)((const char*)(gbase) + (voff)[_i]), (PG8_LAS unsigned*)(lds + (bufoff) + ldsw + _i * 8192), 16, 0, 0); } while (0)
#define PG8_LDA(dst, b, h) do { _Pragma("unroll") for (int m = 0; m < 4; ++m) _Pragma("unroll") for (int k = 0; k < 2; ++k) dst[m][k] = *(const PG8_LAS bf16x8*)(lds + PG8_SA(b, h) + aoff + m * 2048 + k * 1024); } while (0)
#define PG8_LDB(dst, b, h) do { _Pragma("unroll") for (int n = 0; n < 2; ++n) _Pragma("unroll") for (int k = 0; k < 2; ++k) dst[n][k] = *(const PG8_LAS bf16x8*)(lds + PG8_SB(b, h) + boff + n * 2048 + k * 1024); } while (0)
#define PG8_MMA(ai, bj, At, Bt) do { __builtin_amdgcn_s_setprio(1); _Pragma("unroll") for (int m = 0; m < 4; ++m) _Pragma("unroll") for (int n = 0; n < 2; ++n) _Pragma("unroll") for (int k = 0; k < 2; ++k) \
        acc[ai][bj][m][n] = __builtin_amdgcn_mfma_f32_16x16x32_bf16(Bt[n][k], At[m][k], acc[ai][bj][m][n], 0, 0, 0); __builtin_amdgcn_s_setprio(0); } while (0)
#define PG8_WAIT_V(n) asm volatile("s_waitcnt vmcnt(" #n ")" ::: "memory")
#define PG8_WAIT_L(n) asm volatile("s_waitcnt lgkmcnt(" #n ")" ::: "memory")
#define PG8_BAR __builtin_amdgcn_s_barrier()
#define PG8_SCHED __builtin_amdgcn_sched_barrier(0)
    Unit cur, nxt; int ui = 0;
    if (!S.next(0, cur)) return;
    f32x4 acc[2][2][4][2];
#pragma unroll
    for (int a = 0; a < 2; ++a)
#pragma unroll
        for (int b = 0; b < 2; ++b)
#pragma unroll
            for (int m = 0; m < 4; ++m)
#pragma unroll
                for (int n = 0; n < 2; ++n) acc[a][b][m][n] = (f32x4){0.f, 0.f, 0.f, 0.f};
    bf16x8 At[4][2], B0[2][2], B1[2][2];
    const char* cA = (const char*)g.A + (size_t)cur.pm * tstep; const char* cB = (const char*)g.Bt + (size_t)cur.pn * tstep;
    S.a_ready(cur);
    if constexpr (SP2) {
        PG8_STAGE(PG8_SB(0, 0), cB, voffB); PG8_STAGE(PG8_SB(0, 1), cB + hstep, voffB); PG8_STAGE(PG8_SA(0, 0), cA, voffA); PG8_STAGE(PG8_SA(0, 1), cA + hstep, voffA);
        if (wr == 1) PG8_BAR;
        PG8_WAIT_V(2); PG8_BAR;
        PG8_STAGE(PG8_SB(1, 0), cB + kstep, voffB); PG8_STAGE(PG8_SA(1, 0), cA + kstep, voffA); PG8_STAGE(PG8_SB(1, 1), cB + hstep + kstep, voffB);
        PG8_WAIT_V(6); PG8_BAR;
    } else {
        PG8_STAGE(PG8_SB(0, 0), cB, voffB); PG8_STAGE(PG8_SA(0, 0), cA, voffA); PG8_STAGE(PG8_SB(0, 1), cB + hstep, voffB); PG8_STAGE(PG8_SA(0, 1), cA + hstep, voffA);
        if (wr == 1) PG8_BAR;
        PG8_WAIT_V(4); PG8_BAR;
        PG8_STAGE(PG8_SB(1, 0), cB + kstep, voffB); PG8_STAGE(PG8_SA(1, 0), cA + kstep, voffA); PG8_STAGE(PG8_SB(1, 1), cB + hstep + kstep, voffB);
        PG8_WAIT_V(6); PG8_BAR;
    }
    for (;;) {
        const bool has_next = S.next(ui + 1, nxt);
        const char* nA = has_next ? (const char*)g.A + (size_t)nxt.pm * tstep : cA; const char* nB = has_next ? (const char*)g.Bt + (size_t)nxt.pn * tstep : cB;
        for (int t = 0; t < nt; t += 2) {
            const bool last = (t == nt - 2);
            const char* a1 = cA + (size_t)(t + 1) * kstep;
            const char* a2 = last ? nA : cA + (size_t)(t + 2) * kstep; const char* b2 = last ? nB : cB + (size_t)(t + 2) * kstep;
            const char* a3 = a2 + kstep; const char* b3 = b2 + kstep;
            if (last && has_next) S.a_ready(nxt);
            if constexpr (SP2) {
            PG8_LDB(B0, 0, 0); PG8_LDB(B1, 0, 1); PG8_SCHED; PG8_LDA(At, 0, 0); PG8_STAGE(PG8_SA(1, 1), a1 + hstep, voffA);
            PG8_WAIT_V(8); PG8_WAIT_L(0); PG8_BAR; PG8_MMA(0, 0, At, B0); PG8_MMA(0, 1, At, B1); PG8_BAR; PG8_SCHED;
            PG8_LDA(At, 0, 1); PG8_STAGE(PG8_SB(0, 0), b2, voffB); PG8_STAGE(PG8_SB(0, 1), b2 + hstep, voffB); PG8_STAGE(PG8_SA(0, 0), a2, voffA);
            PG8_WAIT_V(8); PG8_WAIT_L(0); PG8_BAR; PG8_MMA(1, 0, At, B0); PG8_MMA(1, 1, At, B1); PG8_BAR; PG8_SCHED;
            PG8_LDB(B0, 1, 0); PG8_LDB(B1, 1, 1); PG8_SCHED; PG8_LDA(At, 1, 0); PG8_STAGE(PG8_SA(0, 1), a2 + hstep, voffA);
            PG8_WAIT_V(8); PG8_WAIT_L(0); PG8_BAR; PG8_MMA(0, 0, At, B0); PG8_MMA(0, 1, At, B1); PG8_BAR; PG8_SCHED;
            PG8_LDA(At, 1, 1); PG8_STAGE(PG8_SB(1, 0), b3, voffB); PG8_STAGE(PG8_SB(1, 1), b3 + hstep, voffB); PG8_STAGE(PG8_SA(1, 0), a3, voffA);
            PG8_WAIT_V(8); PG8_WAIT_L(0); PG8_BAR; PG8_MMA(1, 0, At, B0); PG8_MMA(1, 1, At, B1); PG8_BAR; PG8_SCHED;
            } else {
            PG8_LDB(B0, 0, 0); PG8_SCHED; PG8_LDA(At, 0, 0); PG8_STAGE(PG8_SA(1, 1), a1 + hstep, voffA);
            PG8_WAIT_L(8); PG8_BAR; PG8_WAIT_L(0); PG8_MMA(0, 0, At, B0); PG8_BAR; PG8_SCHED;
            PG8_LDB(B1, 0, 1); PG8_STAGE(PG8_SB(0, 0), b2, voffB);
            PG8_BAR; PG8_WAIT_L(0); PG8_MMA(0, 1, At, B1); PG8_BAR;
            PG8_LDA(At, 0, 1); PG8_STAGE(PG8_SA(0, 0), a2, voffA);
            PG8_BAR; PG8_WAIT_L(0); PG8_MMA(1, 0, At, B0); PG8_BAR; PG8_SCHED;
            PG8_STAGE(PG8_SB(0, 1), b2 + hstep, voffB);
            PG8_WAIT_V(6); PG8_BAR; PG8_MMA(1, 1, At, B1); PG8_BAR;
            PG8_LDB(B0, 1, 0); PG8_SCHED; PG8_LDA(At, 1, 0); PG8_STAGE(PG8_SA(0, 1), a2 + hstep, voffA);
            PG8_WAIT_L(8); PG8_BAR; PG8_WAIT_L(0); PG8_MMA(0, 0, At, B0); PG8_BAR; PG8_SCHED;
            PG8_LDB(B1, 1, 1); PG8_STAGE(PG8_SB(1, 0), b3, voffB);
            PG8_BAR; PG8_WAIT_L(0); PG8_MMA(0, 1, At, B1); PG8_BAR;
            PG8_LDA(At, 1, 1); PG8_STAGE(PG8_SA(1, 0), a3, voffA);
            PG8_BAR; PG8_WAIT_L(0); PG8_MMA(1, 0, At, B0); PG8_BAR; PG8_SCHED;
            PG8_STAGE(PG8_SB(1, 1), b3 + hstep, voffB);
            PG8_WAIT_V(6); PG8_BAR; PG8_MMA(1, 1, At, B1); PG8_BAR;
            }
        }
        if constexpr (ALIGN_EPI) { if (wr == 0) PG8_BAR; }
        if constexpr (!Epi::AFTER_DRAIN) { E(acc, cur, wr, wc, fr, fq); S.done(cur); }
        if (!has_next) break;
#pragma unroll
        for (int a = 0; a < 2; ++a)
#pragma unroll
            for (int b = 0; b < 2; ++b)
#pragma unroll
                for (int m = 0; m < 4; ++m)
#pragma unroll
                    for (int n = 0; n < 2; ++n) acc[a][b][m][n] = (f32x4){0.f, 0.f, 0.f, 0.f};
        cur = nxt; cA = nA; cB = nB; ++ui;
        if constexpr (ALIGN_EPI) { if (wr == 1) PG8_BAR; }
    }
    PG8_WAIT_V(0);
    if constexpr (!ALIGN_EPI) { if (wr == 0) PG8_BAR; }
    PG8_BAR;
    if constexpr (Epi::AFTER_DRAIN) { E.fused(acc, cur, wr, wc, fr, fq, lds, wid, lane); S.done(cur); }
#undef PG8_SA
#undef PG8_SB
#undef PG8_STAGE
#undef PG8_LDA
#undef PG8_LDB
#undef PG8_MMA
#undef PG8_WAIT_V
#undef PG8_WAIT_L
#undef PG8_BAR
#undef PG8_SCHED
}
}
#define GAS __attribute__((address_space(1)))
#define LAS __attribute__((address_space(3)))
typedef unsigned short bf16;
typedef unsigned v4u __attribute__((ext_vector_type(4)));
typedef float f32x4 __attribute__((ext_vector_type(4)));
typedef short bf16x8 __attribute__((ext_vector_type(8)));
typedef GAS unsigned gu32;
typedef GAS unsigned long long gu64;
#define RLX_AGENT __ATOMIC_RELAXED, __HIP_MEMORY_SCOPE_AGENT
#define LDS_WAIT() asm volatile("s_waitcnt lgkmcnt(0)" ::: "memory")
#define VM_WAIT() asm volatile("s_waitcnt vmcnt(0)" ::: "memory")
__device__ __forceinline__ unsigned long long rt() { return __builtin_amdgcn_s_memrealtime(); }
__device__ __forceinline__ unsigned f2bf(float f) { unsigned u = __builtin_bit_cast(unsigned, f); return (u + 0x7fffu + ((u >> 16) & 1u)) >> 16; }
__device__ __forceinline__ unsigned pk2(float lo, float hi) { return f2bf(lo) | (f2bf(hi) << 16); }

#define XB_TMO      128
#define XB_XCNT(j)  (256  + 64 * (j))
#define XB_XSUB(j)  (1280 + 64 * (j))
#define XB_XGEN(j)  (2304 + 64 * (j))
#define XB_TOP      3328
#define XB_TOPGEN   3392
#define XCD_BAR_WORDS 3456
#define XB_SPIN_CAP (1u << 18)

__device__ __forceinline__ unsigned xb_ld(unsigned* p)              { return __hip_atomic_load(p, __ATOMIC_RELAXED, __HIP_MEMORY_SCOPE_AGENT); }
__device__ __forceinline__ unsigned xb_add(unsigned* p, unsigned v) { return __hip_atomic_fetch_add(p, v, __ATOMIC_RELAXED, __HIP_MEMORY_SCOPE_AGENT); }
__device__ __forceinline__ unsigned xb_xcc_id() { return (unsigned)__builtin_amdgcn_s_getreg((3 << 11) | 20) & 0xFu; }
#define XB_SPIN(cond, bar) do { unsigned _sp = 0; while (cond) { __builtin_amdgcn_s_sleep(1); \
    if ((++_sp & 255u) == 0u) { if (xb_ld(&(bar)[XB_TMO])) break; if (_sp > XB_SPIN_CAP) { atomicAdd(&(bar)[XB_TMO], 1u); break; } } } } while (0)

struct XcdBarrier {
    unsigned* bar; unsigned x;
    volatile LAS unsigned* st;
};

__device__ __forceinline__ XcdBarrier xcd_barrier_post(unsigned* bar, volatile LAS unsigned* st) {
    XcdBarrier b; b.bar = bar; b.x = xb_xcc_id(); b.st = st;
    if (threadIdx.x == 0) (void)xb_add(&bar[XB_XCNT(b.x)], 1u);
    return b;
}
__device__ __forceinline__ void xcd_barrier_complete(unsigned* bar, unsigned x, unsigned& nloc, unsigned& nx) {
    const unsigned G = gridDim.x * gridDim.y * gridDim.z;
    unsigned sum, cnt, mine, sp = 0u;
    for (;;) {
        sum = 0u; cnt = 0u; mine = 0u;
#pragma unroll
        for (unsigned j = 0; j < 16; ++j) { const unsigned c = xb_ld(&bar[XB_XCNT(j)]); sum += c; cnt += (c > 0u) ? 1u : 0u; mine = (j == x) ? c : mine; }
        if (sum == G) break;
        __builtin_amdgcn_s_sleep(1);
        if ((++sp & 255u) == 0u) { if (xb_ld(&bar[XB_TMO])) break; if (sp > XB_SPIN_CAP) { atomicAdd(&bar[XB_TMO], 1u); break; } }
    }
    nloc = mine > 0u ? mine : 1u; nx = cnt > 0u ? cnt : 1u;
}

__device__ __forceinline__ void xcd_barrier(const XcdBarrier& b) {
    asm volatile("s_waitcnt vmcnt(0)" ::: "memory");
    __syncthreads();
    if (threadIdx.x == 0) {
        unsigned* bar = b.bar;
        __builtin_amdgcn_s_waitcnt(0);
        unsigned nloc = b.st[0], nx = b.st[1];
        if (nloc == 0u) { xcd_barrier_complete(bar, b.x, nloc, nx); b.st[0] = nloc; b.st[1] = nx; }
        const unsigned old = xb_add(&bar[XB_XSUB(b.x)], 1u);
        const unsigned gen = old / nloc;
        if (old + 1u == (gen + 1u) * nloc) {
            __builtin_amdgcn_fence(__ATOMIC_RELEASE, "agent");
            asm volatile("s_waitcnt vmcnt(0)" ::: "memory");
            const unsigned og = xb_add(&bar[XB_TOP], 1u);
            const unsigned tg = og / nx;
            if (og + 1u == (tg + 1u) * nx) xb_add(&bar[XB_TOPGEN], 1u);
            else XB_SPIN(xb_ld(&bar[XB_TOPGEN]) == tg, bar);
            __builtin_amdgcn_fence(__ATOMIC_ACQUIRE, "agent");
            xb_add(&bar[XB_XGEN(b.x)], 1u);
            asm volatile("s_waitcnt vmcnt(0)" ::: "memory");
        } else {
            XB_SPIN(xb_ld(&bar[XB_XGEN(b.x)]) == gen, bar);
            __builtin_amdgcn_fence(__ATOMIC_ACQUIRE, "agent");
            asm volatile("s_waitcnt vmcnt(0)" ::: "memory");
        }
    }
    __syncthreads();
}

constexpr int NWAVES = 8, NTHR = NWAVES * 64;
constexpr int D = 1024, NCTX_B = 16, SEQ = 256, DEPTH = 4, NLAT_B = 4, LSEQ = 2048, PAST = 512;
constexpr int NCTX = NCTX_B * SEQ, NLAT = NLAT_B * LSEQ, NTOK = NCTX + NLAT;
constexpr int GWID = 64, NH = 16, DH = 64, CK = 31, NMG = 5;
constexpr float EPS = 1e-6f;
constexpr float LOG2E_F = 1.4426950408889634f;

constexpr size_t MiB = 1u << 20;
constexpr size_t WS_CTL = 0, CTL_ZERO_BYTES = 64 * 1024;
constexpr int CW_BAR = 4096;
constexpr size_t WS_MOD = 1 * MiB;
constexpr size_t WS_GS = WS_MOD + 256 * 1024;
constexpr size_t WS_BIAS = WS_MOD + 512 * 1024;
constexpr size_t WS_SSP = 2 * MiB;
constexpr size_t WS_WCI = 4 * MiB;
constexpr size_t WS_WCO = WS_WCI + 2 * (size_t)3072 * 1024 * 2;
constexpr size_t WS_WNI = WS_WCO + 2 * (size_t)1024 * 1024 * 2;
constexpr size_t WS_WNO = WS_WNI + 2 * (size_t)4096 * 1024 * 2;
constexpr size_t WS_CKB = 44 * MiB;
constexpr size_t WS_CVB = WS_CKB + (size_t)NLAT_B * 2 * PAST * D * 2;
constexpr size_t ACT_BYTES = (size_t)NTOK * D * 2;
constexpr size_t WS_XS = 64 * MiB, WS_G = 88 * MiB, WS_B0 = 112 * MiB, WS_B1 = 136 * MiB, WS_B2 = 160 * MiB, WS_B3 = 184 * MiB, WS_END = 208 * MiB;
static_assert(WS_WNO + 2 * (size_t)1024 * 1024 * 2 <= WS_CKB && WS_CVB + (size_t)NLAT_B * 2 * PAST * D * 2 <= WS_XS && ACT_BYTES <= 24 * MiB, "d_ws map");

constexpr int RING_OFF = 0, RING_BYTES = 131072;
constexpr int LDSCTL_OFF = RING_BYTES, MISC_OFF = LDSCTL_OFF + 320;
constexpr int LDS_BYTES = 147456;

struct Args {
    const float* in[19]; float* out; unsigned char* ws; int ph_lo, ph_hi;
};

struct Frame {
    LAS unsigned char* lds; volatile LAS unsigned* MISC; gu32* ctl;
    int tid, lane, wave, vcu, G;
};

__device__ __forceinline__ int opaque(int x) { asm volatile("" : "+v"(x)); return x; }
__device__ __forceinline__ float wave_sum(float v) {
#pragma unroll
    for (int o = 1; o < 64; o <<= 1) v += __shfl_xor(v, o);
    return v;
}
__device__ __forceinline__ float bf2f(unsigned short b) { return __builtin_bit_cast(float, (unsigned)b << 16); }
__device__ __forceinline__ float bflo(unsigned w) { return __builtin_bit_cast(float, w << 16); }
__device__ __forceinline__ float bfhi(unsigned w) { return __builtin_bit_cast(float, w & 0xffff0000u); }
__device__ __forceinline__ float silu_f(float x) { return x * __builtin_amdgcn_rcpf(1.0f + __builtin_amdgcn_exp2f(-LOG2E_F * x)); }

__device__ __forceinline__ void transpose_item(const float* W, int K, int N, bf16* WT, int k0, int n0, int dst_row0, LAS float* scr, int lane) {
#pragma unroll 8
    for (int i = 0; i < 32; ++i) { const int kk = 2 * i + (lane >> 5); scr[kk * 33 + (lane & 31)] = W[(size_t)(k0 + kk) * N + n0 + (lane & 31)]; }
    LDS_WAIT(); asm volatile("" ::: "memory");
    const int c = lane & 7;
#pragma unroll
    for (int j = 0; j < 4; ++j) { const int n = (lane >> 3) + 8 * j; const LAS float* s = scr + (8 * c) * 33 + n;
        v4u o; o.x = pk2(s[0 * 33], s[1 * 33]); o.y = pk2(s[2 * 33], s[3 * 33]); o.z = pk2(s[4 * 33], s[5 * 33]); o.w = pk2(s[6 * 33], s[7 * 33]);
        *(GAS v4u*)(WT + (size_t)(dst_row0 + n) * K + k0 + 8 * c) = o; }
    LDS_WAIT(); asm volatile("" ::: "memory");
}
__device__ __forceinline__ int conv_in_row(int n) { return n < 1024 ? ((n >> 7) * 256 + (n & 127)) : (n < 2048 ? (((n - 1024) >> 7) * 256 + 128 + (n & 127)) : n); }

__device__ __forceinline__ void phase_p0a(Frame& F, const Args& a) {
    const float* c = a.in[2]; const float* cache_k = a.in[3]; const float* cache_v = a.in[4]; const float* c_ctx = a.in[5];
    const float* ada_w = a.in[7]; const float* ada_b = a.in[8];
    float* mod = (float*)(a.ws + WS_MOD);
    {
        LAS float* sc = (LAS float*)(F.lds);
        LAS float* red = (LAS float*)(F.lds + 20480);
        for (int i = F.tid; i < NMG * D; i += NTHR) { const int v = i >> 10, k = i & 1023; const float x = v == 0 ? c_ctx[k] : c[(v - 1) * D + k]; sc[i] = silu_f(x); }
        __syncthreads();
        for (int it = blockIdx.x; it < DEPTH * 48; it += F.G) {
            const int layer = it / 48, n0 = (it % 48) * 64;
            const float* w = ada_w + (size_t)layer * D * 3 * D + n0 + F.lane;
            float acc[NMG] = {0.f, 0.f, 0.f, 0.f, 0.f};
            const int kb = F.wave * 128;
#pragma unroll 8
            for (int k = 0; k < 128; ++k) { const float wv = w[(size_t)(kb + k) * 3 * D];
#pragma unroll
                for (int v = 0; v < NMG; ++v) acc[v] += sc[v * D + kb + k] * wv; }
#pragma unroll
            for (int v = 0; v < NMG; ++v) red[(F.wave * NMG + v) * 64 + F.lane] = acc[v];
            __syncthreads();
            if (F.tid < NMG * 64) { const int v = F.tid >> 6, l = F.tid & 63; float s = 0.f;
#pragma unroll
                for (int w8 = 0; w8 < 8; ++w8) s += red[(w8 * NMG + v) * 64 + l];
                mod[((size_t)v * DEPTH + layer) * 3 * D + n0 + l] = s + ada_b[layer * 3 * D + n0 + l]; }
            __syncthreads();
        }
        __syncthreads();
    }
    {
        LAS float* scr = (LAS float*)(F.lds + F.wave * 16384);
        const int gw = F.vcu * NWAVES + F.wave, NGW = F.G * NWAVES;
        constexpr int I_CI = 16 * 96, I_CO = 16 * 32, I_NI = 16 * 128, I_NO = 16 * 32;
        constexpr int NITEMS = 2 * (I_CI + I_CO + I_NI + I_NO);
        for (int it = gw; it < NITEMS; it += NGW) {
            int r = it;
            if (r < 2 * I_CI) { const int j = r / I_CI; r %= I_CI; const int kb = r / 96, nb = r % 96;
                transpose_item(a.in[9] + (size_t)j * D * 3072, D, 3072, (bf16*)(a.ws + WS_WCI) + (size_t)j * 3072 * D, kb * 64, nb * 32, conv_in_row(nb * 32), scr, F.lane); continue; }
            r -= 2 * I_CI;
            if (r < 2 * I_CO) { const int j = r / I_CO; r %= I_CO; const int kb = r / 32, nb = r % 32;
                transpose_item(a.in[14] + (size_t)j * D * D, D, D, (bf16*)(a.ws + WS_WCO) + (size_t)j * D * D, kb * 64, nb * 32, nb * 32, scr, F.lane); continue; }
            r -= 2 * I_CO;
            if (r < 2 * I_NI) { const int j = r / I_NI; r %= I_NI; const int kb = r / 128, nb = r % 128;
                transpose_item(a.in[15] + (size_t)j * D * 4096, D, 4096, (bf16*)(a.ws + WS_WNI) + (size_t)j * 4096 * D, kb * 64, nb * 32, nb * 32, scr, F.lane); continue; }
            r -= 2 * I_NI;
            { const int j = r / I_NO; r %= I_NO; const int kb = r / 32, nb = r % 32;
                transpose_item(a.in[17] + (size_t)j * D * D, D, D, (bf16*)(a.ws + WS_WNO) + (size_t)j * D * D, kb * 64, nb * 32, nb * 32, scr, F.lane); }
        }
        constexpr int CITEMS = NLAT_B * 2 * PAST * D / 512;
        for (int it = gw; it < 2 * CITEMS; it += NGW) {
            const bool isv = it >= CITEMS; const int r = isv ? it - CITEMS : it;
            const float* src = (isv ? cache_v : cache_k) + (size_t)r * 512 + F.lane * 8;
            bf16* dst = (bf16*)(a.ws + (isv ? WS_CVB : WS_CKB)) + (size_t)r * 512 + F.lane * 8;
            const f32x4 x0 = *(const f32x4*)src, x1 = *(const f32x4*)(src + 4);
            v4u o; o.x = pk2(x0[0], x0[1]); o.y = pk2(x0[2], x0[3]); o.z = pk2(x1[0], x1[1]); o.w = pk2(x1[2], x1[3]);
            *(v4u*)dst = o;
        }
    }
}

__device__ __forceinline__ void phase_p0b(Frame& F, const Args& a) {
    const float* mod = (const float*)(a.ws + WS_MOD); const float* norm_g = a.in[6];
    float* GS = (float*)(a.ws + WS_GS); float* BIAS = (float*)(a.ws + WS_BIAS); float* ssp = (float*)(a.ws + WS_SSP);
    bf16* XS = (bf16*)(a.ws + WS_XS);
    const int gw = F.vcu * NWAVES + F.wave, NGW = F.G * NWAVES;
    for (int i = (blockIdx.x * NTHR + F.tid); i < DEPTH * NMG * D; i += F.G * NTHR) { const int layer = i / (NMG * D), mg = (i / D) % NMG, k = i % D;
        GS[i] = norm_g[layer * D + k] * (1.0f + mod[((size_t)mg * DEPTH + layer) * 3 * D + D + k]); }
    for (int t = gw; t < NTOK; t += NGW) {
        const float* xr = t < NCTX ? a.in[0] + (size_t)t * D : a.in[1] + (size_t)(t - NCTX) * D;
        const int mg = t < NCTX ? 0 : 1 + (t - NCTX) / LSEQ;
        const float* sc = mod + ((size_t)mg * DEPTH + 0) * 3 * D + D; const float* ng = norm_g;
        float s = 0.f;
#pragma unroll
        for (int jj = 0; jj < 4; ++jj) { const int k = jj * 256 + F.lane * 4; const f32x4 v = *(const f32x4*)(xr + k); const f32x4 g4 = *(const f32x4*)(ng + k); const f32x4 s4 = *(const f32x4*)(sc + k);
            s += (v[0] * v[0] + v[1] * v[1]) + (v[2] * v[2] + v[3] * v[3]);
            const f32x4 o = v * g4 * (s4 + 1.0f);
            unsigned long long w = (unsigned long long)pk2(o[0], o[1]) | ((unsigned long long)pk2(o[2], o[3]) << 32);
            *(unsigned long long*)(XS + (size_t)t * D + k) = w; }
        s = wave_sum(s);
        if (F.lane < 16) ssp[(size_t)t * 16 + F.lane] = F.lane == 0 ? s : 0.f;
    }
    {
        LAS float* sh = (LAS float*)F.lds;
        int cur_layer = -1;
        for (int it = blockIdx.x; it < 224; it += F.G) {
            int layer, chunk; if (it < 48) { layer = 0; chunk = it; } else if (it < 112) { layer = 1; chunk = it - 48; } else if (it < 160) { layer = 2; chunk = it - 112; } else { layer = 3; chunk = it - 160; }
            if (layer != cur_layer) { __syncthreads();
                for (int i = F.tid; i < NMG * D; i += NTHR) sh[i] = mod[((size_t)(i >> 10) * DEPTH + layer) * 3 * D + (i & 1023)];
                cur_layer = layer; __syncthreads(); }
            const bf16* WT = (layer & 1) ? (const bf16*)(a.ws + WS_WNI) + (size_t)(layer >> 1) * 4096 * D : (const bf16*)(a.ws + WS_WCI) + (size_t)(layer >> 1) * 3072 * D;
            for (int rr = 0; rr < 8; ++rr) { const int n = chunk * 64 + F.wave * 8 + rr;
                const v4u w0 = *(const v4u*)(WT + (size_t)n * D + F.lane * 16), w1 = *(const v4u*)(WT + (size_t)n * D + F.lane * 16 + 8);
                float wf[16] = {bflo(w0.x), bfhi(w0.x), bflo(w0.y), bfhi(w0.y), bflo(w0.z), bfhi(w0.z), bflo(w0.w), bfhi(w0.w),
                                bflo(w1.x), bfhi(w1.x), bflo(w1.y), bfhi(w1.y), bflo(w1.z), bfhi(w1.z), bflo(w1.w), bfhi(w1.w)};
#pragma unroll
                for (int v = 0; v < NMG; ++v) { float s = 0.f;
#pragma unroll
                    for (int q = 0; q < 16; ++q) s += wf[q] * sh[v * D + F.lane * 16 + q];
                    s = wave_sum(s);
                    if (F.lane == 0) BIAS[((size_t)layer * NMG + v) * 4096 + n] = s; } }
        }
    }
}


constexpr int CONV_TT = 16, CONV_ROWS = CONV_TT + CK - 1;
__device__ __forceinline__ void phase_conv(Frame& F, const Args& a, int j) {
    const bf16* U = (const bf16*)(a.ws + WS_B0); const bf16* SZ = (const bf16*)(a.ws + WS_B1); bf16* Gb = (bf16*)(a.ws + WS_G);
    const float* dw_w = a.in[10] + (size_t)j * CK * D; const float* dw_b = a.in[11] + j * D; const float* ln_g = a.in[12] + j * D; const float* ln_b = a.in[13] + j * D;
    const int tid = opaque(F.tid), lane = tid & 63;
    typedef float f32x2 __attribute__((ext_vector_type(2)));
    f32x2 w[CK];
#pragma unroll
    for (int k = 0; k < CK; ++k) w[k] = *(const f32x2*)(dw_w + k * D + 2 * tid);
    const f32x2 cb = *(const f32x2*)(dw_b + 2 * tid), lg = *(const f32x2*)(ln_g + 2 * tid), lb = *(const f32x2*)(ln_b + 2 * tid);
    LAS unsigned char* rows = F.lds;
    LAS float* red = (LAS float*)(F.lds + CONV_ROWS * 2048);
    LAS float* stats = red + 256;
    for (int item = blockIdx.x; item < NTOK / CONV_TT; item += F.G) {
        const int t0 = item * CONV_TT;
        int s0, len; if (t0 < NCTX) { s0 = (t0 / SEQ) * SEQ; len = SEQ; } else { s0 = NCTX + ((t0 - NCTX) / LSEQ) * LSEQ; len = LSEQ; }
        for (int q = tid; q < CONV_ROWS * 128; q += NTHR) { const int row = q >> 7, ch = q & 127; const int tok = t0 - (CK / 2) + row;
            v4u v = {0u, 0u, 0u, 0u};
            if (tok >= s0 && tok < s0 + len) v = *(const v4u*)(U + (size_t)tok * D + ch * 8);
            *(LAS v4u*)(rows + row * 2048 + ch * 16) = v; }
        unsigned szw[CONV_TT];
#pragma unroll
        for (int l = 0; l < CONV_TT; ++l) szw[l] = *(const unsigned*)(SZ + (size_t)(t0 + l) * D + 2 * tid);
        __syncthreads();
        float o0[CONV_TT], o1[CONV_TT];
#pragma unroll
        for (int l = 0; l < CONV_TT; ++l) { o0[l] = cb.x; o1[l] = cb.y; }
#pragma unroll
        for (int r = 0; r < CONV_ROWS; ++r) { const unsigned uw = *(const LAS unsigned*)(rows + r * 2048 + tid * 4); const float u0 = bflo(uw), u1 = bfhi(uw);
#pragma unroll
            for (int l = 0; l < CONV_TT; ++l) { const int k = r - l; if (k >= 0 && k < CK) { o0[l] += u0 * w[k].x; o1[l] += u1 * w[k].y; } }
            if ((r & 3) == 3) asm volatile("" ::: "memory"); }
        float v[32];
#pragma unroll
        for (int l = 0; l < CONV_TT; ++l) { v[l] = o0[l] + o1[l]; v[16 + l] = o0[l] * o0[l] + o1[l] * o1[l]; }
#pragma unroll
        for (int s = 0; s < 5; ++s) { const int hn = 16 >> s; const unsigned upm = 0u - ((unsigned)(lane >> s) & 1u);
#pragma unroll
            for (int i = 0; i < hn; ++i) { const unsigned a_ = __float_as_uint(v[i]), b_ = __float_as_uint(v[i + hn]);
                const float keep = __uint_as_float((b_ & upm) | (a_ & ~upm)), send = __uint_as_float((a_ & upm) | (b_ & ~upm)); v[i] = keep + __shfl_xor(send, 1 << s); } }
        v[0] += __shfl_xor(v[0], 32);
        if (lane < 32) { const int idx = ((lane & 1) << 4) | ((lane & 2) << 2) | (lane & 4) | ((lane & 8) >> 2) | ((lane & 16) >> 4); red[F.wave * 32 + idx] = v[0]; }
        __syncthreads();
        if (tid < 32) { float s = 0.f;
#pragma unroll
            for (int w8 = 0; w8 < 8; ++w8) s += red[w8 * 32 + tid];
            stats[tid] = s; }
        __syncthreads();
#pragma unroll
        for (int l = 0; l < CONV_TT; ++l) { const float mu = stats[l] * (1.0f / D); const float var = stats[16 + l] * (1.0f / D) - mu * mu; const float rstd = __builtin_amdgcn_rsqf(var + EPS);
            const float y0 = (o0[l] - mu) * rstd * lg.x + lb.x, y1 = (o1[l] - mu) * rstd * lg.y + lb.y;
            *(unsigned*)(Gb + (size_t)(t0 + l) * D + 2 * tid) = pk2(silu_f(y0) * bflo(szw[l]), silu_f(y1) * bfhi(szw[l])); }
    }
    __syncthreads();
}

namespace att {
typedef float f32x16 __attribute__((ext_vector_type(16)));
typedef short s16x4 __attribute__((ext_vector_type(4)));
constexpr int SLOT = 16384, KOFF = 0, VOFF = 8192, TBL_OFF = 32768, WSF_OFF = 34816;
constexpr float THR = 8.0f, NEG = -1.0e30f;
__device__ __forceinline__ int crow(int r, int hi) { return (r & 3) + 8 * (r >> 2) + 4 * hi; }
__device__ __forceinline__ unsigned cvtpk(float lo, float hi) { unsigned r; asm volatile("v_cvt_pk_bf16_f32 %0, %1, %2" : "=v"(r) : "v"(lo), "v"(hi)); return r; }
__device__ __forceinline__ s16x4 vtr(const LAS unsigned char* p) { return __builtin_bit_cast(s16x4, __builtin_amdgcn_ds_read_tr16_b64_v4i16((LAS s16x4*)p)); }
__device__ __forceinline__ float swapmax(float m) { auto rr = __builtin_amdgcn_permlane32_swap(__float_as_uint(m), __float_as_uint(m), false, false); return fmaxf(__uint_as_float(rr[0]), __uint_as_float(rr[1])); }
__device__ __forceinline__ float swapadd(float m) { auto rr = __builtin_amdgcn_permlane32_swap(__float_as_uint(m), __float_as_uint(m), false, false); return __uint_as_float(rr[0]) + __uint_as_float(rr[1]); }
struct Params { const bf16 *Q, *K, *V, *SZ, *CK, *CV; bf16* G; const float* rpb; int j; };

template <int NP> __device__ __forceinline__ void softmax_step(f32x16 (&p)[2], float& m, float& l, f32x16 (&o)[2], LAS float* wsf, int r32, int hi) {
    float rm = p[0][0];
#pragma unroll
    for (int r = 1; r < 16; ++r) rm = fmaxf(rm, p[0][r]);
    if (NP == 2) {
#pragma unroll
        for (int r = 0; r < 16; ++r) rm = fmaxf(rm, p[1][r]); }
    rm = swapmax(rm);
    if (__any(rm > m + THR)) {
        const float mn = fmaxf(m, rm); const float alpha = __builtin_amdgcn_exp2f(m - mn); m = mn; l *= alpha;
        if (hi == 0) wsf[r32] = alpha;
#pragma unroll
        for (int r = 0; r < 16; ++r) { const float al = wsf[crow(r, hi)]; o[0][r] *= al; o[1][r] *= al; }
    }
    float s = 0.f;
#pragma unroll
    for (int r = 0; r < 16; ++r) { p[0][r] = __builtin_amdgcn_exp2f(p[0][r] - m); s += p[0][r]; }
    if (NP == 2) {
#pragma unroll
        for (int r = 0; r < 16; ++r) { p[1][r] = __builtin_amdgcn_exp2f(p[1][r] - m); s += p[1][r]; } }
    l += s;
}
__device__ __forceinline__ bf16x8 packp(const f32x16& p, int s8) {
    v4u w; w.x = cvtpk(p[s8 + 0], p[s8 + 1]); w.y = cvtpk(p[s8 + 2], p[s8 + 3]); w.z = cvtpk(p[s8 + 4], p[s8 + 5]); w.w = cvtpk(p[s8 + 6], p[s8 + 7]);
    return __builtin_bit_cast(bf16x8, w);
}

__device__ __forceinline__ void attn_unit(Frame& F, const Params& P, int u) {
    const int tid = opaque(F.tid), lane = tid & 63, wid = F.wave, r32 = lane & 31, hi = lane >> 5;
    LAS unsigned char* lds = F.lds;
    LAS float* tbl = (LAS float*)(lds + TBL_OFF);
    LAS float* wsf = (LAS float*)(lds + WSF_OFF) + wid * 32;
    const bool is_na = u < 512;
    int b, h, ntiles, rlo = 0, r0 = 0;
    if (is_na) { b = u >> 7; h = (u >> 3) & 15; r0 = 4 * (u & 7); rlo = r0 - 4; rlo = rlo < 0 ? 0 : rlo; int rh = r0 - 1; rh = rh < 0 ? 0 : (rh > 24 ? 24 : rh); ntiles = 8 + (rh + 7 - rlo + 1); }
    else { const int uu = u - 512; b = uu >> 4; h = uu & 15; ntiles = 4; }
    int tq, rq = 0, cq = 0, bs = 0;
    if (is_na) { const int jb = wid >> 1; rq = r0 + 2 * (wid & 1) + (r32 >> 4); cq = 16 * jb + (r32 & 15); tq = NCTX + b * LSEQ + rq * GWID + cq; bs = jb == 0 ? 0 : (jb == 1 ? 8 : (jb == 2 ? 24 : 32)); }
    else tq = b * SEQ + wid * 32 + r32;
    int rsq = rq - 4; rsq = rsq < 0 ? 0 : (rsq > 24 ? 24 : rsq);
    int qs = cq - 8; qs = qs < 0 ? 0 : (qs > 48 ? 48 : qs);
    const int srow = tid >> 3, sch = tid & 7;
    const unsigned kst = sch * 1024 + srow * 16, vst = VOFF + (sch >> 2) * 4096 + (srow >> 3) * 512 + (srow & 7) * 64 + (sch & 3) * 16;
    const size_t lane_off = (size_t)srow * D + h * DH + sch * 8;
    v4u rk, rv;
#define ATT_TILE_PTRS(t, kp, vp) do { if (is_na && (t) < 8) { const size_t o_ = ((size_t)(b * 2 + P.j) * PAST + 64 * (t)) * D + lane_off; kp = P.CK + o_; vp = P.CV + o_; } \
        else { const size_t o_ = (is_na ? (size_t)(NCTX + b * LSEQ + (rlo + (t) - 8) * GWID) : (size_t)(b * SEQ + 64 * (t))) * D + lane_off; kp = P.K + o_; vp = P.V + o_; } } while (0)
    { const bf16 *kp, *vp; ATT_TILE_PTRS(0, kp, vp); rk = *(const v4u*)kp; rv = *(const v4u*)vp; }
    if (is_na) { for (int i = tid; i < 15 * 31; i += NTHR) tbl[i] = P.rpb[((size_t)P.j * NH + h) * 465 + i] * LOG2E_F; }
    bf16x8 qr[4];
#pragma unroll
    for (int d0 = 0; d0 < 4; ++d0) qr[d0] = *(const bf16x8*)(P.Q + (size_t)tq * D + h * DH + d0 * 16 + hi * 8);
    *(LAS v4u*)(lds + kst) = rk; *(LAS v4u*)(lds + vst) = rv;
    __syncthreads();
    float m = NEG, l = 0.f; f32x16 o[2];
#pragma unroll
    for (int r = 0; r < 16; ++r) { o[0][r] = 0.f; o[1][r] = 0.f; }
    const unsigned vrd = VOFF + ((lane >> 4) & 1) * 32 + (lane & 3) * 8 + (4 * hi + ((lane & 15) >> 2)) * 64;
    for (int t = 0; t < ntiles; ++t) {
        if (t + 1 < ntiles) { const bf16 *kp, *vp; ATT_TILE_PTRS(t + 1, kp, vp); rk = *(const v4u*)kp; rv = *(const v4u*)vp; }
        const LAS unsigned char* slot = lds + (t & 1) * SLOT;
        f32x16 p[2];
#pragma unroll
        for (int r = 0; r < 16; ++r) { p[0][r] = 0.f; p[1][r] = 0.f; }
        if (!is_na || t < 8) {
            const LAS unsigned char* kb = slot + hi * 1024 + r32 * 16;
#pragma unroll
            for (int d0 = 0; d0 < 4; ++d0) { const bf16x8 k0 = *(const LAS bf16x8*)(kb + d0 * 2048), k1 = *(const LAS bf16x8*)(kb + d0 * 2048 + 512);
                p[0] = __builtin_amdgcn_mfma_f32_32x32x16_bf16(k0, qr[d0], p[0], 0, 0, 0); p[1] = __builtin_amdgcn_mfma_f32_32x32x16_bf16(k1, qr[d0], p[1], 0, 0, 0); }
            softmax_step<2>(p, m, l, o, wsf, r32, hi);
            const bf16x8 pa0 = packp(p[0], 0), pa1 = packp(p[0], 8), pa2 = packp(p[1], 0), pa3 = packp(p[1], 8);
            const LAS unsigned char* vb = slot + vrd;
#pragma unroll
            for (int d0 = 0; d0 < 2; ++d0) {
#pragma unroll
                for (int ks = 0; ks < 4; ++ks) { const s16x4 lo = vtr(vb + d0 * 4096 + ks * 1024), h4 = vtr(vb + d0 * 4096 + ks * 1024 + 512);
                    const bf16x8 vf = (bf16x8){lo[0], lo[1], lo[2], lo[3], h4[0], h4[1], h4[2], h4[3]};
                    o[d0] = __builtin_amdgcn_mfma_f32_32x32x16_bf16(ks == 0 ? pa0 : (ks == 1 ? pa1 : (ks == 2 ? pa2 : pa3)), vf, o[d0], 0, 0, 0); } }
        } else {
            const int rr = rlo + t - 8;
            const LAS unsigned char* kb = slot + hi * 1024 + (bs + r32) * 16;
#pragma unroll
            for (int d0 = 0; d0 < 4; ++d0) { const bf16x8 k0 = *(const LAS bf16x8*)(kb + d0 * 2048); p[0] = __builtin_amdgcn_mfma_f32_32x32x16_bf16(k0, qr[d0], p[0], 0, 0, 0); }
            const bool rowok = rr >= rsq && rr < rsq + 8;
            const int tb = (rr - rq + 7) * 31 - cq + 15;
#pragma unroll
            for (int r = 0; r < 16; ++r) { const int kc = bs + crow(r, hi); const bool ok = rowok && kc >= qs && kc < qs + 16; const float bias = tbl[ok ? tb + kc : 0]; p[0][r] = ok ? p[0][r] + bias : NEG; }
            softmax_step<1>(p, m, l, o, wsf, r32, hi);
            const bf16x8 pa0 = packp(p[0], 0), pa1 = packp(p[0], 8);
            const LAS unsigned char* vb = slot + vrd + (bs >> 3) * 512;
#pragma unroll
            for (int d0 = 0; d0 < 2; ++d0) {
#pragma unroll
                for (int ks = 0; ks < 2; ++ks) { const s16x4 lo = vtr(vb + d0 * 4096 + ks * 1024), h4 = vtr(vb + d0 * 4096 + ks * 1024 + 512);
                    const bf16x8 vf = (bf16x8){lo[0], lo[1], lo[2], lo[3], h4[0], h4[1], h4[2], h4[3]};
                    o[d0] = __builtin_amdgcn_mfma_f32_32x32x16_bf16(ks == 0 ? pa0 : pa1, vf, o[d0], 0, 0, 0); } }
        }
        if (t + 1 < ntiles) { LAS unsigned char* nslot = lds + ((t + 1) & 1) * SLOT; *(LAS v4u*)(nslot + kst) = rk; *(LAS v4u*)(nslot + vst) = rv; }
        __syncthreads();
    }
#undef ATT_TILE_PTRS
    l = swapadd(l);
    if (hi == 0) wsf[r32] = __builtin_amdgcn_rcpf(l);
    const int tq0 = tq - r32;
#pragma unroll
    for (int r = 0; r < 16; ++r) { const int qi = crow(r, hi); const float rl = wsf[qi];
        int tok; if (is_na) tok = NCTX + b * LSEQ + (r0 + 2 * (wid & 1) + (qi >> 4)) * GWID + 16 * (wid >> 1) + (qi & 15); else tok = tq0 + qi;
#pragma unroll
        for (int d0 = 0; d0 < 2; ++d0) { const size_t idx = (size_t)tok * D + h * DH + d0 * 32 + r32;
            P.G[idx] = (bf16)f2bf(o[d0][r] * rl * bf2f(P.SZ[idx])); } }
    __syncthreads();
}
}
__device__ __forceinline__ void phase_attn(Frame& F, const Args& a, int j) {
    att::Params P{(const bf16*)(a.ws + WS_B0), (const bf16*)(a.ws + WS_B2), (const bf16*)(a.ws + WS_B3), (const bf16*)(a.ws + WS_B1), (const bf16*)(a.ws + WS_CKB), (const bf16*)(a.ws + WS_CVB),
                  (bf16*)(a.ws + WS_G), a.in[16], j};
    for (int u = F.vcu; u < 768; u += F.G) att::attn_unit(F, P, u);
}

__device__ __forceinline__ void phase_final(Frame& F, const Args& a) {
    const float* ssp = (const float*)(a.ws + WS_SSP); const float* fg = a.in[18];
    const int gw = F.vcu * NWAVES + F.wave, NGW = F.G * NWAVES;
    for (int t = gw; t < NTOK; t += NGW) {
        const float rs = pg8::row_rscale(ssp, t);
        float* xr = a.out + (size_t)t * D;
#pragma unroll
        for (int jj = 0; jj < 4; ++jj) { const int k = jj * 256 + F.lane * 4; f32x4 v = *(const f32x4*)(xr + k); const f32x4 g4 = *(const f32x4*)(fg + k);
            *(f32x4*)(xr + k) = v * rs * g4; }
    }
}

#ifndef MK_ONE_LAUNCH
#define MK_ONE_LAUNCH 0
#endif
constexpr int N_PHASES = 15;
__global__ void __launch_bounds__(NTHR, 2) mk_fwd(Args args) {
    extern __shared__ __attribute__((aligned(16))) unsigned char lds[];
    Frame F;
    F.lds = (LAS unsigned char*)lds;
    F.MISC = (volatile LAS unsigned*)(F.lds + MISC_OFF);
    F.tid = threadIdx.x; asm volatile("" : "+v"(F.tid)); F.lane = F.tid & 63; F.wave = __builtin_amdgcn_readfirstlane(F.tid >> 6);
    F.G = gridDim.x; { const int bx = blockIdx.x; F.vcu = (F.G % 8 == 0) ? (bx % 8) * (F.G / 8) + bx / 8 : bx; }
    unsigned char* ws = args.ws;
    F.ctl = (gu32*)(ws + WS_CTL);
    const int lo = args.ph_lo, hi = args.ph_hi;
#define IN(k) (lo <= (k) && (k) < hi)
    for (int u = F.tid; u < (LDS_BYTES - LDSCTL_OFF) / 4; u += NTHR) ((LAS unsigned*)(F.lds + LDSCTL_OFF))[u] = 0u;
    __syncthreads();
    XcdBarrier bar = xcd_barrier_post((unsigned*)(F.ctl + CW_BAR), F.MISC + 8);
#define BOTH(k) (IN(k) && IN((k) + 1))
#define SEAM(k) do { if (BOTH(k)) xcd_barrier(bar); } while (0)
    if (IN(0)) { phase_p0a(F, args); SEAM(0); }
    if (IN(1)) { phase_p0b(F, args); SEAM(1); }
    bf16* XS = (bf16*)(ws + WS_XS); bf16* G = (bf16*)(ws + WS_G); bf16* B0 = (bf16*)(ws + WS_B0); bf16* B1 = (bf16*)(ws + WS_B1); bf16* B2 = (bf16*)(ws + WS_B2); bf16* B3 = (bf16*)(ws + WS_B3);
    float* ssp = (float*)(ws + WS_SSP); const float* mod = (const float*)(ws + WS_MOD);
    float* x = args.out; float* newk = args.out + (size_t)NTOK * D; float* newv = newk + (size_t)NCTX_B * 2 * SEQ * D;
#pragma unroll 1
    for (int layer = 0; layer < DEPTH; ++layer) {
        const int j = layer >> 1;
        const float* bias = (const float*)(ws + WS_BIAS) + (size_t)layer * NMG * 4096;
        if (IN(2 + 3 * layer)) {
            if ((layer & 1) == 0) {
                pg8::Gemm g{XS, (const bf16*)(ws + WS_WCI) + (size_t)j * 3072 * D, NTOK, 3072, D}; pg8::StaticOrder S; S.init(NTOK, 3072, F.G, (int)blockIdx.x);
                pg8::EpiConv1 E{ssp, bias, B0, B1};
                pg8::gemm_phase<pg8::EpiConv1, pg8::StaticOrder, true, true>(F.lds + RING_OFF, g, S, E);
            } else {
                pg8::Gemm g{XS, (const bf16*)(ws + WS_WNI) + (size_t)j * 4096 * D, NTOK, 4096, D}; pg8::StaticOrder S; S.init(NTOK, 4096, F.G, (int)blockIdx.x);
                pg8::EpiAttn1 E{ssp, bias, B0, (size_t)(WS_B1 - WS_B0) / 2, newk, (size_t)NCTX_B * 2 * SEQ * D, j};
                pg8::gemm_phase<pg8::EpiAttn1, pg8::StaticOrder, true, true>(F.lds + RING_OFF, g, S, E);
            }
            SEAM(2 + 3 * layer);
        }
        if (IN(3 + 3 * layer)) {
#ifndef NO_CONV
            if ((layer & 1) == 0) phase_conv(F, args, j);
#endif
#ifndef NO_ATTN
            if ((layer & 1) == 1) phase_attn(F, args, j);
#endif
            SEAM(3 + 3 * layer);
        }
        if (IN(4 + 3 * layer)) {
            const bf16* WT = (layer & 1) ? (const bf16*)(ws + WS_WNO) + (size_t)j * D * D : (const bf16*)(ws + WS_WCO) + (size_t)j * D * D;
            pg8::Gemm g{G, WT, NTOK, D, D}; pg8::StaticOrder S; S.init(NTOK, D, F.G, (int)blockIdx.x);
            const float* bc = layer == 0 ? args.in[0] : x; const float* bl = layer == 0 ? args.in[1] : x + (size_t)NCTX * D;
            const float* gate = mod + (size_t)layer * 3 * D + 2 * D;
            if (layer < DEPTH - 1) {
                pg8::EpiGemm2<true> E{bc, bl, x, gate, DEPTH * 3 * D, (const float*)(ws + WS_GS) + (size_t)(layer + 1) * NMG * D, XS, ssp};
                pg8::gemm_phase<pg8::EpiGemm2<true>, pg8::StaticOrder, true, true>(F.lds + RING_OFF, g, S, E);
            } else {
                pg8::EpiGemm2<false> E{bc, bl, x, gate, DEPTH * 3 * D, nullptr, XS, ssp};
                pg8::gemm_phase<pg8::EpiGemm2<false>, pg8::StaticOrder, true, true>(F.lds + RING_OFF, g, S, E);
            }
            SEAM(4 + 3 * layer);
        }
    }
    if (IN(14)) phase_final(F, args);
#undef IN
#undef BOTH
#undef SEAM
}

__global__ void __launch_bounds__(256) k_conv_b(const bf16* __restrict__ U, const bf16* __restrict__ SZ, const float* __restrict__ dw_w, const float* __restrict__ dw_b,
                                                 const float* __restrict__ ln_g, const float* __restrict__ ln_b, bf16* __restrict__ Gb) {
    const int t = blockIdx.x;
    int s0, len;
    if (t < NCTX) { s0 = (t / SEQ) * SEQ; len = SEQ; } else { s0 = NCTX + ((t - NCTX) / LSEQ) * LSEQ; len = LSEQ; }
    const int l = t - s0;
    float v[4]; float s = 0.f;
#pragma unroll
    for (int i = 0; i < 4; ++i) {
        int c = threadIdx.x + i * 256;
        float acc = dw_b[c];
        for (int k = 0; k < CK; ++k) { int ll = l + k - CK / 2; if (ll >= 0 && ll < len) acc += bf2f(U[(size_t)(s0 + ll) * D + c]) * dw_w[k * D + c]; }
        v[i] = acc; s += acc;
    }
    __shared__ float red[256];
    red[threadIdx.x] = s; __syncthreads();
    for (int o = 128; o > 0; o >>= 1) { if (threadIdx.x < o) red[threadIdx.x] += red[threadIdx.x + o]; __syncthreads(); }
    const float mu = red[0] / D; __syncthreads();
    float q = 0.f;
#pragma unroll
    for (int i = 0; i < 4; ++i) { float d = v[i] - mu; q += d * d; }
    red[threadIdx.x] = q; __syncthreads();
    for (int o = 128; o > 0; o >>= 1) { if (threadIdx.x < o) red[threadIdx.x] += red[threadIdx.x + o]; __syncthreads(); }
    const float rstd = rsqrtf(red[0] / D + EPS);
#pragma unroll
    for (int i = 0; i < 4; ++i) { int c = threadIdx.x + i * 256; float u = (v[i] - mu) * rstd * ln_g[c] + ln_b[c];
        Gb[(size_t)t * D + c] = (bf16)f2bf(silu_f(u) * bf2f(SZ[(size_t)t * D + c])); }
}

__global__ void __launch_bounds__(256) k_ctx_attn_b(const bf16* __restrict__ Q, const bf16* __restrict__ K, const bf16* __restrict__ V, const bf16* __restrict__ SZ, bf16* __restrict__ Gb) {
    const int t = blockIdx.x, h = blockIdx.y, b = t / SEQ;
    __shared__ float sq[DH]; __shared__ float sp[SEQ]; __shared__ float red[256];
    if (threadIdx.x < DH) sq[threadIdx.x] = bf2f(Q[(size_t)t * D + h * DH + threadIdx.x]);
    __syncthreads();
    const int l = threadIdx.x;
    const bf16* kr = K + (size_t)(b * SEQ + l) * D + h * DH;
    float sc = 0.f;
    for (int d = 0; d < DH; ++d) sc += sq[d] * bf2f(kr[d]);
    red[threadIdx.x] = sc; __syncthreads();
    for (int o = 128; o > 0; o >>= 1) { if (threadIdx.x < o) red[threadIdx.x] = fmaxf(red[threadIdx.x], red[threadIdx.x + o]); __syncthreads(); }
    const float mx = red[0]; __syncthreads();
    const float p = exp2f(sc - mx);
    sp[l] = p; red[threadIdx.x] = p; __syncthreads();
    for (int o = 128; o > 0; o >>= 1) { if (threadIdx.x < o) red[threadIdx.x] += red[threadIdx.x + o]; __syncthreads(); }
    const float inv = 1.f / red[0];
    if (threadIdx.x < DH) { const int d = threadIdx.x; float o = 0.f;
        for (int ll = 0; ll < SEQ; ++ll) o += sp[ll] * bf2f(V[(size_t)(b * SEQ + ll) * D + h * DH + d]);
        const size_t idx = (size_t)t * D + h * DH + d;
        Gb[idx] = (bf16)f2bf(o * inv * bf2f(SZ[idx])); }
}

__global__ void __launch_bounds__(256) k_na_attn_b(const bf16* __restrict__ Q, const bf16* __restrict__ K, const bf16* __restrict__ V, const bf16* __restrict__ SZ,
                                                    const bf16* __restrict__ CKb, const bf16* __restrict__ CVb, const float* __restrict__ rpb, int j, bf16* __restrict__ Gb) {
    const int tl = blockIdx.x, h = blockIdx.y;
    const int b = tl / LSEQ, n = tl % LSEQ, r = n / GWID, c = n % GWID;
    const int t = NCTX + tl;
    __shared__ float sq[DH]; __shared__ float sp[128 + PAST]; __shared__ float red[256];
    if (threadIdx.x < DH) sq[threadIdx.x] = bf2f(Q[(size_t)t * D + h * DH + threadIdx.x]);
    __syncthreads();
    int rs = r - 4; rs = rs < 0 ? 0 : (rs > 24 ? 24 : rs);
    int qs = c - 8; qs = qs < 0 ? 0 : (qs > 48 ? 48 : qs);
    const bf16* ck = CKb + ((size_t)(b * 2 + j) * PAST) * D + h * DH;
    const bf16* cv = CVb + ((size_t)(b * 2 + j) * PAST) * D + h * DH;
    const float* rp = rpb + ((size_t)j * NH + h) * 15 * 31;
    float mx = -3.0e38f;
    for (int i = threadIdx.x; i < 128 + PAST; i += 256) {
        float sc = 0.f;
        if (i < 128) { int rr = rs + i / 16, kc = qs + i % 16;
            const bf16* kr = K + (size_t)(NCTX + b * LSEQ + rr * GWID + kc) * D + h * DH;
            for (int d = 0; d < DH; ++d) sc += sq[d] * bf2f(kr[d]);
            int dr = rr - r + 7, dc = kc - c + 15; dc = dc < 0 ? 0 : (dc > 30 ? 30 : dc);
            sc += rp[dr * 31 + dc] * LOG2E_F;
        } else { const bf16* kr = ck + (size_t)(i - 128) * D; for (int d = 0; d < DH; ++d) sc += sq[d] * bf2f(kr[d]); }
        sp[i] = sc; mx = fmaxf(mx, sc);
    }
    red[threadIdx.x] = mx; __syncthreads();
    for (int o = 128; o > 0; o >>= 1) { if (threadIdx.x < o) red[threadIdx.x] = fmaxf(red[threadIdx.x], red[threadIdx.x + o]); __syncthreads(); }
    mx = red[0]; __syncthreads();
    float ps = 0.f;
    for (int i = threadIdx.x; i < 128 + PAST; i += 256) { float p = exp2f(sp[i] - mx); sp[i] = p; ps += p; }
    red[threadIdx.x] = ps; __syncthreads();
    for (int o = 128; o > 0; o >>= 1) { if (threadIdx.x < o) red[threadIdx.x] += red[threadIdx.x + o]; __syncthreads(); }
    const float inv = 1.f / red[0];
    if (threadIdx.x < DH) { const int d = threadIdx.x; float o = 0.f;
        for (int i = 0; i < 128; ++i) { int rr = rs + i / 16, kc = qs + i % 16; o += sp[i] * bf2f(V[(size_t)(NCTX + b * LSEQ + rr * GWID + kc) * D + h * DH + d]); }
        for (int i = 0; i < PAST; ++i) o += sp[128 + i] * bf2f(cv[(size_t)i * D + d]);
        const size_t idx = (size_t)t * D + h * DH + d;
        Gb[idx] = (bf16)f2bf(o * inv * bf2f(SZ[idx])); }
}

extern "C" void kernel_launch(void* const* d_in, const int* in_sizes, int n_in, void* d_out, int out_size, void* d_ws, size_t ws_size, hipStream_t stream) {
    static int grid = 0;
    if (grid == 0) {
        int dev = 0, cus = 0, per_cu = 0;
        if (n_in != 19 || ws_size < WS_END) { fprintf(stderr, "kernel_launch: unexpected n_in %d / ws %zu\n", n_in, ws_size); grid = -1; return; }
        if (hipGetDevice(&dev) != hipSuccess || hipDeviceGetAttribute(&cus, hipDeviceAttributeMultiprocessorCount, dev) != hipSuccess) { grid = -1; return; }
        if (hipFuncSetAttribute((const void*)mk_fwd, hipFuncAttributeMaxDynamicSharedMemorySize, LDS_BYTES) != hipSuccess) { fprintf(stderr, "kernel_launch: hipFuncSetAttribute failed\n"); grid = -1; return; }
        if (hipOccupancyMaxActiveBlocksPerMultiprocessor(&per_cu, (const void*)mk_fwd, NTHR, LDS_BYTES) != hipSuccess || per_cu < 1) { fprintf(stderr, "kernel_launch: occupancy query says %d\n", per_cu); }
        (void)hipGetLastError();
        grid = cus;
    }
    if (grid < 0) return;
    (void)hipMemsetAsync((char*)d_ws + WS_CTL, 0, CTL_ZERO_BYTES, stream);
    Args a{};
    for (int i = 0; i < 19; ++i) a.in[i] = (const float*)d_in[i];
    a.out = (float*)d_out; a.ws = (unsigned char*)d_ws;
    unsigned char* ws = (unsigned char*)d_ws;
    bf16* G = (bf16*)(ws + WS_G); bf16* B0 = (bf16*)(ws + WS_B0); bf16* B1 = (bf16*)(ws + WS_B1); bf16* B2 = (bf16*)(ws + WS_B2); bf16* B3 = (bf16*)(ws + WS_B3);
    auto run = [&](int lo, int hi) { a.ph_lo = lo; a.ph_hi = hi; hipLaunchKernelGGL(mk_fwd, dim3(grid), dim3(NTHR), LDS_BYTES, stream, a); };
#if MK_ONE_LAUNCH
    run(0, N_PHASES);
#else
    for (int ph = 0; ph < N_PHASES; ++ph) run(ph, ph + 1);
#endif
    (void)G; (void)B0; (void)B1; (void)B2; (void)B3;
}
```

```cpp
#include <hip/hip_runtime.h>
#include <cstdio>
#include <cstdint>
namespace pg8 {
#define PG8_LAS __attribute__((address_space(3)))
typedef unsigned short bf16_t;
typedef short bf16x8 __attribute__((ext_vector_type(8)));
typedef float f32x4 __attribute__((ext_vector_type(4)));
typedef unsigned u32x4 __attribute__((ext_vector_type(4)));
constexpr int BM = 256, BK = 64, HALF = 128, HTB = HALF * BK * 2  , STAGE_BYTES = 8 * HTB, NXCD = 8, WGM = 8;

__host__ __device__ __forceinline__ int lds_byte(int r, int c) { const int st = (r >> 4) * 2 + (c >> 5), rr = r & 15, cc = c & 31, ob = rr * 64 + cc * 2; return st * 1024 + (ob ^ (((ob >> 9) & 1) << 5)); }
__host__ __device__ __forceinline__ void stage_rc(int b, int& R, int& C) { const int st = b / 1024, sb = b % 1024, swz = sb ^ (((sb >> 9) & 1) << 5); R = (st >> 1) * 16 + swz / 64; C = (st & 1) * 32 + (swz % 64) / 2; }
__host__ __device__ __forceinline__ int perm32(int rho) { const int n = rho >> 4, i = rho & 15; return 8 * (i >> 2) + 4 * n + (i & 3); }

struct Unit { int pm, pn; };
struct Gemm { const bf16_t* A; const bf16_t* Bt; int M, N, K; };

struct StaticOrder {
    int nM, nN, nwg, G, c;
    __host__ __device__ void init(int M, int N, int G_, int c_) { nM = M / BM; nN = N / BM; nwg = nM * nN; G = G_; c = c_; }
    __host__ __device__ bool next(int i, Unit& u) const {
        const long L = (long)i * G + c; if (L >= nwg) return false;
        int wgid = (int)L; { const int q = nwg / NXCD, r = nwg % NXCD, xcd = wgid % NXCD, off = wgid / NXCD; wgid = (xcd < r ? xcd * (q + 1) : r * (q + 1) + (xcd - r) * q) + off; }
        const int nig = WGM * nN, gid = wgid / nig, fm = gid * WGM, gsz = (nM - fm) < WGM ? (nM - fm) : WGM;
        u.pm = fm + ((wgid % nig) % gsz); u.pn = (wgid % nig) / gsz; return true;
    }
    __device__ __forceinline__ void a_ready(const Unit&) const {}
    __device__ __forceinline__ void done(const Unit&) const {}
};


__device__ __forceinline__ unsigned cvt_pk_bf16(float lo, float hi) { unsigned r; asm volatile("v_cvt_pk_bf16_f32 %0, %1, %2" : "=v"(r) : "v"(lo), "v"(hi)); return r; }
constexpr int ROWLEN = 1024;
constexpr int NTOKC = 4096;
constexpr float RMS_EPS = 1e-6f;
constexpr float LOG2E = 1.4426950408889634f;
constexpr float QSCALE = 0.125f * LOG2E;
__device__ __forceinline__ int mg_of_tile(int pm) { return pm < 16 ? 0 : 1 + ((pm - 16) >> 3); }
__device__ __forceinline__ float fast_sigmoid(float x) { return __builtin_amdgcn_rcpf(1.0f + __builtin_amdgcn_exp2f(-LOG2E * x)); }
__device__ __forceinline__ f32x4 sigm4(f32x4 v) { return (f32x4){fast_sigmoid(v[0]), fast_sigmoid(v[1]), fast_sigmoid(v[2]), fast_sigmoid(v[3])}; }
__device__ __forceinline__ u32x4 pack8(f32x4 a, f32x4 b) { u32x4 w; w.x = cvt_pk_bf16(a[0], a[1]); w.y = cvt_pk_bf16(a[2], a[3]); w.z = cvt_pk_bf16(b[0], b[1]); w.w = cvt_pk_bf16(b[2], b[3]); return w; }
__device__ __forceinline__ float row_rscale(const float* ssp, int row) {
    const f32x4* p = (const f32x4*)(ssp + (size_t)row * 16);
    const f32x4 a = p[0], b = p[1], c = p[2], d = p[3];
    const f32x4 s = (a + b) + (c + d);
    return __builtin_amdgcn_rsqf(((s[0] + s[1]) + (s[2] + s[3])) * (1.0f / ROWLEN) + RMS_EPS);
}

struct EpiConv1 {
    static constexpr bool PERM = true, AFTER_DRAIN = false;
    const float* ssp; const float* bias  ; bf16_t* U; bf16_t* SZ;
    __device__ __forceinline__ void operator()(const f32x4 (&acc)[2][2][4][2], const Unit& u, int wr, int wc, int fr, int fq) const {
        const int mg = mg_of_tile(u.pm);
        const float* bb = bias + mg * 4096 + u.pn * BM + wc * 32 + 8 * fq;
        f32x4 bv[2][2];
#pragma unroll
        for (int bj = 0; bj < 2; ++bj)
#pragma unroll
            for (int n = 0; n < 2; ++n) bv[bj][n] = *(const f32x4*)(bb + bj * HALF + 4 * n);
        const int row0 = u.pm * BM + wr * 64 + fr;
        if (u.pn < 8) {
            const int col = u.pn * HALF + wc * 32 + 8 * fq;
#pragma unroll
            for (int ai = 0; ai < 2; ++ai)
#pragma unroll
                for (int m = 0; m < 4; ++m) { const int row = row0 + ai * HALF + m * 16; const float rs = row_rscale(ssp, row);
                    const f32x4 a0 = acc[ai][0][m][0] * rs + bv[0][0], a1 = acc[ai][0][m][1] * rs + bv[0][1];
                    const f32x4 b0 = acc[ai][1][m][0] * rs + bv[1][0], b1 = acc[ai][1][m][1] * rs + bv[1][1];
                    *(u32x4*)(U + (size_t)row * ROWLEN + col) = pack8(a0 * sigm4(b0), a1 * sigm4(b1)); }
        } else {
            const int col = (u.pn - 8) * BM + wc * 32 + 8 * fq;
#pragma unroll
            for (int ai = 0; ai < 2; ++ai)
#pragma unroll
                for (int m = 0; m < 4; ++m) { const int row = row0 + ai * HALF + m * 16; const float rs = row_rscale(ssp, row);
#pragma unroll
                    for (int bj = 0; bj < 2; ++bj) { const f32x4 z0 = acc[ai][bj][m][0] * rs + bv[bj][0], z1 = acc[ai][bj][m][1] * rs + bv[bj][1];
                        *(u32x4*)(SZ + (size_t)row * ROWLEN + col + bj * HALF) = pack8(z0 * sigm4(z0), z1 * sigm4(z1)); } }
        }
    }
};

struct EpiAttn1 {
    static constexpr bool PERM = true, AFTER_DRAIN = false;
    const float* ssp; const float* bias; bf16_t* B0; size_t bstride  ; float* newk; size_t nstride  ; int j;
    __device__ __forceinline__ void operator()(const f32x4 (&acc)[2][2][4][2], const Unit& u, int wr, int wc, int fr, int fq) const {
        const int mg = mg_of_tile(u.pm);
        const float* bb = bias + mg * 4096 + u.pn * BM + wc * 32 + 8 * fq;
        f32x4 bv[2][2];
#pragma unroll
        for (int bj = 0; bj < 2; ++bj)
#pragma unroll
            for (int n = 0; n < 2; ++n) bv[bj][n] = *(const f32x4*)(bb + bj * HALF + 4 * n);
        const int row0 = u.pm * BM + wr * 64 + fr;
        const int sect = u.pn >> 2, col = (u.pn & 3) * BM + wc * 32 + 8 * fq;
        const int bidx = sect == 0 ? 0 : (sect == 3 ? 1 : sect + 1);
        bf16_t* dst = B0 + (size_t)bidx * bstride;
        float* cdst = newk + (sect == 2 ? nstride : (size_t)0);
        const bool cache = (sect == 1 || sect == 2) && u.pm < 16;
        const float qs = sect == 0 ? QSCALE : 1.0f;
#pragma unroll
        for (int ai = 0; ai < 2; ++ai)
#pragma unroll
            for (int m = 0; m < 4; ++m) { const int row = row0 + ai * HALF + m * 16; const float rs = row_rscale(ssp, row);
#pragma unroll
                for (int bj = 0; bj < 2; ++bj) { f32x4 v0 = acc[ai][bj][m][0] * rs + bv[bj][0], v1 = acc[ai][bj][m][1] * rs + bv[bj][1];
                    if (cache) { float* cp = cdst + ((size_t)(u.pm * 2 + j) * 256 + (row - u.pm * BM)) * ROWLEN + col + bj * HALF; *(f32x4*)cp = v0; *(f32x4*)(cp + 4) = v1; }
                    v0 = v0 * qs; v1 = v1 * qs;
                    if (sect == 3) { v0 = v0 * sigm4(v0); v1 = v1 * sigm4(v1); }
                    *(u32x4*)(dst + (size_t)row * ROWLEN + col + bj * HALF) = pack8(v0, v1); } }
    }
};

template <bool HAS_NEXT> struct EpiGemm2 {
    static constexpr bool PERM = true, AFTER_DRAIN = false;
    const float* base_ctx; const float* base_lat; float* out; const float* gate  ; int gate_stride; const float* gsn  ; bf16_t* XS; float* ssp;
    __device__ __forceinline__ void operator()(const f32x4 (&acc)[2][2][4][2], const Unit& u, int wr, int wc, int fr, int fq) const {
        const int mg = mg_of_tile(u.pm);
        const int col = u.pn * BM + wc * 32 + 8 * fq;
        f32x4 gv[2][2], sv[2][2];
#pragma unroll
        for (int bj = 0; bj < 2; ++bj)
#pragma unroll
            for (int n = 0; n < 2; ++n) { gv[bj][n] = *(const f32x4*)(gate + (size_t)mg * gate_stride + col + bj * HALF + 4 * n);
                if (HAS_NEXT) sv[bj][n] = *(const f32x4*)(gsn + mg * ROWLEN + col + bj * HALF + 4 * n); }
        const int row0 = u.pm * BM + wr * 64 + fr;
        const float* base = u.pm < 16 ? base_ctx : base_lat - (size_t)NTOKC * ROWLEN;
#pragma unroll
        for (int ai = 0; ai < 2; ++ai)
#pragma unroll
            for (int m = 0; m < 4; ++m) { const int row = row0 + ai * HALF + m * 16; float sq = 0.f;
#pragma unroll
                for (int bj = 0; bj < 2; ++bj) { const size_t off = (size_t)row * ROWLEN + col + bj * HALF;
                    const f32x4 x0 = *(const f32x4*)(base + off) + gv[bj][0] * acc[ai][bj][m][0], x1 = *(const f32x4*)(base + off + 4) + gv[bj][1] * acc[ai][bj][m][1];
                    *(f32x4*)(out + off) = x0; *(f32x4*)(out + off + 4) = x1;
                    sq += (x0[0] * x0[0] + x0[1] * x0[1]) + (x0[2] * x0[2] + x0[3] * x0[3]) + (x1[0] * x1[0] + x1[1] * x1[1]) + (x1[2] * x1[2] + x1[3] * x1[3]);
                    if (HAS_NEXT) *(u32x4*)(XS + off) = pack8(x0 * sv[bj][0], x1 * sv[bj][1]); }
                sq += __shfl_xor(sq, 16); sq += __shfl_xor(sq, 32);
                if (fq == 0) ssp[(size_t)row * 16 + u.pn * 4 + wc] = sq; }
    }
};
template <class Epi, class Sched, bool ALIGN_EPI = false, bool SP2 = false>
__device__ __forceinline__ void gemm_phase(PG8_LAS unsigned char* lds, const Gemm g, const Sched& S, const Epi& E) {
    int tid_ = threadIdx.x; asm volatile("" : "+v"(tid_));
    const int tid = tid_, wid = __builtin_amdgcn_readfirstlane(tid >> 6), lane = tid & 63, wr = wid >> 2, wc = wid & 3, fr = lane & 15, fq = lane >> 4;
    const int K = g.K, nt = K / BK;
    unsigned voffA[2], voffB[2];
#pragma unroll
    for (int i = 0; i < 2; ++i) { int R, C; stage_rc(tid * 16 + i * 8192, R, C); const int Rb = Epi::PERM ? ((R & ~31) + perm32(R & 31)) : R;
        voffA[i] = (unsigned)(R * K + C) * 2u; voffB[i] = (unsigned)(Rb * K + C) * 2u; }
    const size_t kstep = (size_t)(BK * 2);
    const size_t hstep = (size_t)HALF * K * 2;
    const size_t tstep = 2 * hstep;
    const unsigned ldsw = (unsigned)wid * 1024u;
    const int aoff = lds_byte(wr * 64 + fr, fq * 8), boff = lds_byte(wc * 32 + fr, fq * 8);
#define PG8_SA(b, h) (((b) * 2 + (h)) * HTB)
#define PG8_SB(b, h) ((4 + (b) * 2 + (h)) * HTB)
#define PG8_STAGE(bufoff, gbase, voff) do { _Pragma("unroll") for (int _i = 0; _i < 2; ++_i) \
        __builtin_amdgcn_global_load_lds((const unsigned*)((const char*)(gbase) + (voff)[_i]), (PG8_LAS unsigned*)(lds + (bufoff) + ldsw + _i * 8192), 16, 0, 0); } while (0)
#define PG8_LDA(dst, b, h) do { _Pragma("unroll") for (int m = 0; m < 4; ++m) _Pragma("unroll") for (int k = 0; k < 2; ++k) dst[m][k] = *(const PG8_LAS bf16x8*)(lds + PG8_SA(b, h) + aoff + m * 2048 + k * 1024); } while (0)
#define PG8_LDB(dst, b, h) do { _Pragma("unroll") for (int n = 0; n < 2; ++n) _Pragma("unroll") for (int k = 0; k < 2; ++k) dst[n][k] = *(const PG8_LAS bf16x8*)(lds + PG8_SB(b, h) + boff + n * 2048 + k * 1024); } while (0)
#define PG8_MMA(ai, bj, At, Bt) do { __builtin_amdgcn_s_setprio(1); _Pragma("unroll") for (int m = 0; m < 4; ++m) _Pragma("unroll") for (int n = 0; n < 2; ++n) _Pragma("unroll") for (int k = 0; k < 2; ++k) \
        acc[ai][bj][m][n] = __builtin_amdgcn_mfma_f32_16x16x32_bf16(Bt[n][k], At[m][k], acc[ai][bj][m][n], 0, 0, 0); __builtin_amdgcn_s_setprio(0); } while (0)
#define PG8_WAIT_V(n) asm volatile("s_waitcnt vmcnt(" #n ")" ::: "memory")
#define PG8_WAIT_L(n) asm volatile("s_waitcnt lgkmcnt(" #n ")" ::: "memory")
#define PG8_BAR __builtin_amdgcn_s_barrier()
#define PG8_SCHED __builtin_amdgcn_sched_barrier(0)
    Unit cur, nxt; int ui = 0;
    if (!S.next(0, cur)) return;
    f32x4 acc[2][2][4][2];
#pragma unroll
    for (int a = 0; a < 2; ++a)
#pragma unroll
        for (int b = 0; b < 2; ++b)
#pragma unroll
            for (int m = 0; m < 4; ++m)
#pragma unroll
                for (int n = 0; n < 2; ++n) acc[a][b][m][n] = (f32x4){0.f, 0.f, 0.f, 0.f};
    bf16x8 At[4][2], B0[2][2], B1[2][2];
    const char* cA = (const char*)g.A + (size_t)cur.pm * tstep; const char* cB = (const char*)g.Bt + (size_t)cur.pn * tstep;
    S.a_ready(cur);
    if constexpr (SP2) {
        PG8_STAGE(PG8_SB(0, 0), cB, voffB); PG8_STAGE(PG8_SB(0, 1), cB + hstep, voffB); PG8_STAGE(PG8_SA(0, 0), cA, voffA); PG8_STAGE(PG8_SA(0, 1), cA + hstep, voffA);
        if (wr == 1) PG8_BAR;
        PG8_WAIT_V(2); PG8_BAR;
        PG8_STAGE(PG8_SB(1, 0), cB + kstep, voffB); PG8_STAGE(PG8_SA(1, 0), cA + kstep, voffA); PG8_STAGE(PG8_SB(1, 1), cB + hstep + kstep, voffB);
        PG8_WAIT_V(6); PG8_BAR;
    } else {
        PG8_STAGE(PG8_SB(0, 0), cB, voffB); PG8_STAGE(PG8_SA(0, 0), cA, voffA); PG8_STAGE(PG8_SB(0, 1), cB + hstep, voffB); PG8_STAGE(PG8_SA(0, 1), cA + hstep, voffA);
        if (wr == 1) PG8_BAR;
        PG8_WAIT_V(4); PG8_BAR;
        PG8_STAGE(PG8_SB(1, 0), cB + kstep, voffB); PG8_STAGE(PG8_SA(1, 0), cA + kstep, voffA); PG8_STAGE(PG8_SB(1, 1), cB + hstep + kstep, voffB);
        PG8_WAIT_V(6); PG8_BAR;
    }
    for (;;) {
        const bool has_next = S.next(ui + 1, nxt);
        const char* nA = has_next ? (const char*)g.A + (size_t)nxt.pm * tstep : cA; const char* nB = has_next ? (const char*)g.Bt + (size_t)nxt.pn * tstep : cB;
        for (int t = 0; t < nt; t += 2) {
            const bool last = (t == nt - 2);
            const char* a1 = cA + (size_t)(t + 1) * kstep;
            const char* a2 = last ? nA : cA + (size_t)(t + 2) * kstep; const char* b2 = last ? nB : cB + (size_t)(t + 2) * kstep;
            const char* a3 = a2 + kstep; const char* b3 = b2 + kstep;
            if (last && has_next) S.a_ready(nxt);
            if constexpr (SP2) {
            PG8_LDB(B0, 0, 0); PG8_LDB(B1, 0, 1); PG8_SCHED; PG8_LDA(At, 0, 0); PG8_STAGE(PG8_SA(1, 1), a1 + hstep, voffA);
            PG8_WAIT_V(8); PG8_WAIT_L(0); PG8_BAR; PG8_MMA(0, 0, At, B0); PG8_MMA(0, 1, At, B1); PG8_BAR; PG8_SCHED;
            PG8_LDA(At, 0, 1); PG8_STAGE(PG8_SB(0, 0), b2, voffB); PG8_STAGE(PG8_SB(0, 1), b2 + hstep, voffB); PG8_STAGE(PG8_SA(0, 0), a2, voffA);
            PG8_WAIT_V(8); PG8_WAIT_L(0); PG8_BAR; PG8_MMA(1, 0, At, B0); PG8_MMA(1, 1, At, B1); PG8_BAR; PG8_SCHED;
            PG8_LDB(B0, 1, 0); PG8_LDB(B1, 1, 1); PG8_SCHED; PG8_LDA(At, 1, 0); PG8_STAGE(PG8_SA(0, 1), a2 + hstep, voffA);
            PG8_WAIT_V(8); PG8_WAIT_L(0); PG8_BAR; PG8_MMA(0, 0, At, B0); PG8_MMA(0, 1, At, B1); PG8_BAR; PG8_SCHED;
            PG8_LDA(At, 1, 1); PG8_STAGE(PG8_SB(1, 0), b3, voffB); PG8_STAGE(PG8_SB(1, 1), b3 + hstep, voffB); PG8_STAGE(PG8_SA(1, 0), a3, voffA);
            PG8_WAIT_V(8); PG8_WAIT_L(0); PG8_BAR; PG8_MMA(1, 0, At, B0); PG8_MMA(1, 1, At, B1); PG8_BAR; PG8_SCHED;
            } else {
            PG8_LDB(B0, 0, 0); PG8_SCHED; PG8_LDA(At, 0, 0); PG8_STAGE(PG8_SA(1, 1), a1 + hstep, voffA);
            PG8_WAIT_L(8); PG8_BAR; PG8_WAIT_L(0); PG8_MMA(0, 0, At, B0); PG8_BAR; PG8_SCHED;
            PG8_LDB(B1, 0, 1); PG8_STAGE(PG8_SB(0, 0), b2, voffB);
            PG8_BAR; PG8_WAIT_L(0); PG8_MMA(0, 1, At, B1); PG8_BAR;
            PG8_LDA(At, 0, 1); PG8_STAGE(PG8_SA(0, 0), a2, voffA);
            PG8_BAR; PG8_WAIT_L(0); PG8_MMA(1, 0, At, B0); PG8_BAR; PG8_SCHED;
            PG8_STAGE(PG8_SB(0, 1), b2 + hstep, voffB);
            PG8_WAIT_V(6); PG8_BAR; PG8_MMA(1, 1, At, B1); PG8_BAR;
            PG8_LDB(B0, 1, 0); PG8_SCHED; PG8_LDA(At, 1, 0); PG8_STAGE(PG8_SA(0, 1), a2 + hstep, voffA);
            PG8_WAIT_L(8); PG8_BAR; PG8_WAIT_L(0); PG8_MMA(0, 0, At, B0); PG8_BAR; PG8_SCHED;
            PG8_LDB(B1, 1, 1); PG8_STAGE(PG8_SB(1, 0), b3, voffB);
            PG8_BAR; PG8_WAIT_L(0); PG8_MMA(0, 1, At, B1); PG8_BAR;
            PG8_LDA(At, 1, 1); PG8_STAGE(PG8_SA(1, 0), a3, voffA);
            PG8_BAR; PG8_WAIT_L(0); PG8_MMA(1, 0, At, B0); PG8_BAR; PG8_SCHED;
            PG8_STAGE(PG8_SB(1, 1), b3 + hstep, voffB);
            PG8_WAIT_V(6); PG8_BAR; PG8_MMA(1, 1, At, B1); PG8_BAR;
            }
        }
        if constexpr (ALIGN_EPI) { if (wr == 0) PG8_BAR; }
        if constexpr (!Epi::AFTER_DRAIN) { E(acc, cur, wr, wc, fr, fq); S.done(cur); }
        if (!has_next) break;
#pragma unroll
        for (int a = 0; a < 2; ++a)
#pragma unroll
            for (int b = 0; b < 2; ++b)
#pragma unroll
                for (int m = 0; m < 4; ++m)
#pragma unroll
                    for (int n = 0; n < 2; ++n) acc[a][b][m][n] = (f32x4){0.f, 0.f, 0.f, 0.f};
        cur = nxt; cA = nA; cB = nB; ++ui;
        if constexpr (ALIGN_EPI) { if (wr == 1) PG8_BAR; }
    }
    PG8_WAIT_V(0);
    if constexpr (!ALIGN_EPI) { if (wr == 0) PG8_BAR; }
    PG8_BAR;
    if constexpr (Epi::AFTER_DRAIN) { E.fused(acc, cur, wr, wc, fr, fq, lds, wid, lane); S.done(cur); }
#undef PG8_SA
#undef PG8_SB
#undef PG8_STAGE
#undef PG8_LDA
#undef PG8_LDB
#undef PG8_MMA
#undef PG8_WAIT_V
#undef PG8_WAIT_L
#undef PG8_BAR
#undef PG8_SCHED
}
}
#define GAS __attribute__((address_space(1)))
#define LAS __attribute__((address_space(3)))
typedef unsigned short bf16;
typedef unsigned v4u __attribute__((ext_vector_type(4)));
typedef float f32x4 __attribute__((ext_vector_type(4)));
typedef short bf16x8 __attribute__((ext_vector_type(8)));
typedef GAS unsigned gu32;
typedef GAS unsigned long long gu64;
#define RLX_AGENT __ATOMIC_RELAXED, __HIP_MEMORY_SCOPE_AGENT
#define LDS_WAIT() asm volatile("s_waitcnt lgkmcnt(0)" ::: "memory")
#define VM_WAIT() asm volatile("s_waitcnt vmcnt(0)" ::: "memory")
__device__ __forceinline__ unsigned long long rt() { return __builtin_amdgcn_s_memrealtime(); }
__device__ __forceinline__ unsigned f2bf(float f) { unsigned u = __builtin_bit_cast(unsigned, f); return (u + 0x7fffu + ((u >> 16) & 1u)) >> 16; }
__device__ __forceinline__ unsigned pk2(float lo, float hi) { return f2bf(lo) | (f2bf(hi) << 16); }

#define XB_TMO      128
#define XB_XCNT(j)  (256  + 64 * (j))
#define XB_XSUB(j)  (1280 + 64 * (j))
#define XB_XGEN(j)  (2304 + 64 * (j))
#define XB_TOP      3328
#define XB_TOPGEN   3392
#define XCD_BAR_WORDS 3456
#define XB_SPIN_CAP (1u << 18)

__device__ __forceinline__ unsigned xb_ld(unsigned* p)              { return __hip_atomic_load(p, __ATOMIC_RELAXED, __HIP_MEMORY_SCOPE_AGENT); }
__device__ __forceinline__ unsigned xb_add(unsigned* p, unsigned v) { return __hip_atomic_fetch_add(p, v, __ATOMIC_RELAXED, __HIP_MEMORY_SCOPE_AGENT); }
__device__ __forceinline__ unsigned xb_xcc_id() { return (unsigned)__builtin_amdgcn_s_getreg((3 << 11) | 20) & 0xFu; }
#define XB_SPIN(cond, bar) do { unsigned _sp = 0; while (cond) { __builtin_amdgcn_s_sleep(1); \
    if ((++_sp & 255u) == 0u) { if (xb_ld(&(bar)[XB_TMO])) break; if (_sp > XB_SPIN_CAP) { atomicAdd(&(bar)[XB_TMO], 1u); break; } } } } while (0)

struct XcdBarrier {
    unsigned* bar; unsigned x;
    volatile LAS unsigned* st;
};

__device__ __forceinline__ XcdBarrier xcd_barrier_post(unsigned* bar, volatile LAS unsigned* st) {
    XcdBarrier b; b.bar = bar; b.x = xb_xcc_id(); b.st = st;
    if (threadIdx.x == 0) (void)xb_add(&bar[XB_XCNT(b.x)], 1u);
    return b;
}
__device__ __forceinline__ void xcd_barrier_complete(unsigned* bar, unsigned x, unsigned& nloc, unsigned& nx) {
    const unsigned G = gridDim.x * gridDim.y * gridDim.z;
    unsigned sum, cnt, mine, sp = 0u;
    for (;;) {
        sum = 0u; cnt = 0u; mine = 0u;
#pragma unroll
        for (unsigned j = 0; j < 16; ++j) { const unsigned c = xb_ld(&bar[XB_XCNT(j)]); sum += c; cnt += (c > 0u) ? 1u : 0u; mine = (j == x) ? c : mine; }
        if (sum == G) break;
        __builtin_amdgcn_s_sleep(1);
        if ((++sp & 255u) == 0u) { if (xb_ld(&bar[XB_TMO])) break; if (sp > XB_SPIN_CAP) { atomicAdd(&bar[XB_TMO], 1u); break; } }
    }
    nloc = mine > 0u ? mine : 1u; nx = cnt > 0u ? cnt : 1u;
}

__device__ __forceinline__ void xcd_barrier(const XcdBarrier& b) {
    asm volatile("s_waitcnt vmcnt(0)" ::: "memory");
    __syncthreads();
    if (threadIdx.x == 0) {
        unsigned* bar = b.bar;
        __builtin_amdgcn_s_waitcnt(0);
        unsigned nloc = b.st[0], nx = b.st[1];
        if (nloc == 0u) { xcd_barrier_complete(bar, b.x, nloc, nx); b.st[0] = nloc; b.st[1] = nx; }
        const unsigned old = xb_add(&bar[XB_XSUB(b.x)], 1u);
        const unsigned gen = old / nloc;
        if (old + 1u == (gen + 1u) * nloc) {
            __builtin_amdgcn_fence(__ATOMIC_RELEASE, "agent");
            asm volatile("s_waitcnt vmcnt(0)" ::: "memory");
            const unsigned og = xb_add(&bar[XB_TOP], 1u);
            const unsigned tg = og / nx;
            if (og + 1u == (tg + 1u) * nx) xb_add(&bar[XB_TOPGEN], 1u);
            else XB_SPIN(xb_ld(&bar[XB_TOPGEN]) == tg, bar);
            __builtin_amdgcn_fence(__ATOMIC_ACQUIRE, "agent");
            xb_add(&bar[XB_XGEN(b.x)], 1u);
            asm volatile("s_waitcnt vmcnt(0)" ::: "memory");
        } else {
            XB_SPIN(xb_ld(&bar[XB_XGEN(b.x)]) == gen, bar);
            __builtin_amdgcn_fence(__ATOMIC_ACQUIRE, "agent");
            asm volatile("s_waitcnt vmcnt(0)" ::: "memory");
        }
    }
    __syncthreads();
}

constexpr int NWAVES = 8, NTHR = NWAVES * 64;
constexpr int D = 1024, NCTX_B = 16, SEQ = 256, DEPTH = 4, NLAT_B = 4, LSEQ = 2048, PAST = 512;
constexpr int NCTX = NCTX_B * SEQ, NLAT = NLAT_B * LSEQ, NTOK = NCTX + NLAT;
constexpr int GWID = 64, NH = 16, DH = 64, CK = 31, NMG = 5;
constexpr float EPS = 1e-6f;
constexpr float LOG2E_F = 1.4426950408889634f;

constexpr size_t MiB = 1u << 20;
constexpr size_t WS_CTL = 0, CTL_ZERO_BYTES = 64 * 1024;
constexpr int CW_BAR = 4096;
constexpr size_t WS_MOD = 1 * MiB;
constexpr size_t WS_GS = WS_MOD + 256 * 1024;
constexpr size_t WS_BIAS = WS_MOD + 512 * 1024;
constexpr size_t WS_SSP = 2 * MiB;
constexpr size_t WS_WCI = 4 * MiB;
constexpr size_t WS_WCO = WS_WCI + 2 * (size_t)3072 * 1024 * 2;
constexpr size_t WS_WNI = WS_WCO + 2 * (size_t)1024 * 1024 * 2;
constexpr size_t WS_WNO = WS_WNI + 2 * (size_t)4096 * 1024 * 2;
constexpr size_t WS_CKB = 44 * MiB;
constexpr size_t WS_CVB = WS_CKB + (size_t)NLAT_B * 2 * PAST * D * 2;
constexpr size_t ACT_BYTES = (size_t)NTOK * D * 2;
constexpr size_t WS_XS = 64 * MiB, WS_G = 88 * MiB, WS_B0 = 112 * MiB, WS_B1 = 136 * MiB, WS_B2 = 160 * MiB, WS_B3 = 184 * MiB, WS_END = 208 * MiB;
static_assert(WS_WNO + 2 * (size_t)1024 * 1024 * 2 <= WS_CKB && WS_CVB + (size_t)NLAT_B * 2 * PAST * D * 2 <= WS_XS && ACT_BYTES <= 24 * MiB, "d_ws map");

constexpr int RING_OFF = 0, RING_BYTES = 131072;
constexpr int LDSCTL_OFF = RING_BYTES, MISC_OFF = LDSCTL_OFF + 320;
constexpr int LDS_BYTES = 147456;

struct Args {
    const float* in[19]; float* out; unsigned char* ws; int ph_lo, ph_hi;
};

struct Frame {
    LAS unsigned char* lds; volatile LAS unsigned* MISC; gu32* ctl;
    int tid, lane, wave, vcu, G;
};

__device__ __forceinline__ int opaque(int x) { asm volatile("" : "+v"(x)); return x; }
__device__ __forceinline__ float wave_sum(float v) {
#pragma unroll
    for (int o = 1; o < 64; o <<= 1) v += __shfl_xor(v, o);
    return v;
}
__device__ __forceinline__ float bf2f(unsigned short b) { return __builtin_bit_cast(float, (unsigned)b << 16); }
__device__ __forceinline__ float bflo(unsigned w) { return __builtin_bit_cast(float, w << 16); }
__device__ __forceinline__ float bfhi(unsigned w) { return __builtin_bit_cast(float, w & 0xffff0000u); }
__device__ __forceinline__ float silu_f(float x) { return x * __builtin_amdgcn_rcpf(1.0f + __builtin_amdgcn_exp2f(-LOG2E_F * x)); }

__device__ __forceinline__ void transpose_item(const float* W, int K, int N, bf16* WT, int k0, int n0, int dst_row0, LAS float* scr, int lane) {
#pragma unroll 8
    for (int i = 0; i < 32; ++i) { const int kk = 2 * i + (lane >> 5); scr[kk * 33 + (lane & 31)] = W[(size_t)(k0 + kk) * N + n0 + (lane & 31)]; }
    LDS_WAIT(); asm volatile("" ::: "memory");
    const int c = lane & 7;
#pragma unroll
    for (int j = 0; j < 4; ++j) { const int n = (lane >> 3) + 8 * j; const LAS float* s = scr + (8 * c) * 33 + n;
        v4u o; o.x = pk2(s[0 * 33], s[1 * 33]); o.y = pk2(s[2 * 33], s[3 * 33]); o.z = pk2(s[4 * 33], s[5 * 33]); o.w = pk2(s[6 * 33], s[7 * 33]);
        *(GAS v4u*)(WT + (size_t)(dst_row0 + n) * K + k0 + 8 * c) = o; }
    LDS_WAIT(); asm volatile("" ::: "memory");
}
__device__ __forceinline__ int conv_in_row(int n) { return n < 1024 ? ((n >> 7) * 256 + (n & 127)) : (n < 2048 ? (((n - 1024) >> 7) * 256 + 128 + (n & 127)) : n); }

__device__ __forceinline__ void phase_p0a(Frame& F, const Args& a) {
    const float* c = a.in[2]; const float* cache_k = a.in[3]; const float* cache_v = a.in[4]; const float* c_ctx = a.in[5];
    const float* ada_w = a.in[7]; const float* ada_b = a.in[8];
    float* mod = (float*)(a.ws + WS_MOD);
    {
        LAS float* sc = (LAS float*)(F.lds);
        LAS float* red = (LAS float*)(F.lds + 20480);
        for (int i = F.tid; i < NMG * D; i += NTHR) { const int v = i >> 10, k = i & 1023; const float x = v == 0 ? c_ctx[k] : c[(v - 1) * D + k]; sc[i] = silu_f(x); }
        __syncthreads();
        for (int it = blockIdx.x; it < DEPTH * 48; it += F.G) {
            const int layer = it / 48, n0 = (it % 48) * 64;
            const float* w = ada_w + (size_t)layer * D * 3 * D + n0 + F.lane;
            float acc[NMG] = {0.f, 0.f, 0.f, 0.f, 0.f};
            const int kb = F.wave * 128;
#pragma unroll 8
            for (int k = 0; k < 128; ++k) { const float wv = w[(size_t)(kb + k) * 3 * D];
#pragma unroll
                for (int v = 0; v < NMG; ++v) acc[v] += sc[v * D + kb + k] * wv; }
#pragma unroll
            for (int v = 0; v < NMG; ++v) red[(F.wave * NMG + v) * 64 + F.lane] = acc[v];
            __syncthreads();
            if (F.tid < NMG * 64) { const int v = F.tid >> 6, l = F.tid & 63; float s = 0.f;
#pragma unroll
                for (int w8 = 0; w8 < 8; ++w8) s += red[(w8 * NMG + v) * 64 + l];
                mod[((size_t)v * DEPTH + layer) * 3 * D + n0 + l] = s + ada_b[layer * 3 * D + n0 + l]; }
            __syncthreads();
        }
        __syncthreads();
    }
    {
        LAS float* scr = (LAS float*)(F.lds + F.wave * 16384);
        const int gw = F.vcu * NWAVES + F.wave, NGW = F.G * NWAVES;
        constexpr int I_CI = 16 * 96, I_CO = 16 * 32, I_NI = 16 * 128, I_NO = 16 * 32;
        constexpr int NITEMS = 2 * (I_CI + I_CO + I_NI + I_NO);
        for (int it = gw; it < NITEMS; it += NGW) {
            int r = it;
            if (r < 2 * I_CI) { const int j = r / I_CI; r %= I_CI; const int kb = r / 96, nb = r % 96;
                transpose_item(a.in[9] + (size_t)j * D * 3072, D, 3072, (bf16*)(a.ws + WS_WCI) + (size_t)j * 3072 * D, kb * 64, nb * 32, conv_in_row(nb * 32), scr, F.lane); continue; }
            r -= 2 * I_CI;
            if (r < 2 * I_CO) { const int j = r / I_CO; r %= I_CO; const int kb = r / 32, nb = r % 32;
                transpose_item(a.in[14] + (size_t)j * D * D, D, D, (bf16*)(a.ws + WS_WCO) + (size_t)j * D * D, kb * 64, nb * 32, nb * 32, scr, F.lane); continue; }
            r -= 2 * I_CO;
            if (r < 2 * I_NI) { const int j = r / I_NI; r %= I_NI; const int kb = r / 128, nb = r % 128;
                transpose_item(a.in[15] + (size_t)j * D * 4096, D, 4096, (bf16*)(a.ws + WS_WNI) + (size_t)j * 4096 * D, kb * 64, nb * 32, nb * 32, scr, F.lane); continue; }
            r -= 2 * I_NI;
            { const int j = r / I_NO; r %= I_NO; const int kb = r / 32, nb = r % 32;
                transpose_item(a.in[17] + (size_t)j * D * D, D, D, (bf16*)(a.ws + WS_WNO) + (size_t)j * D * D, kb * 64, nb * 32, nb * 32, scr, F.lane); }
        }
        constexpr int CITEMS = NLAT_B * 2 * PAST * D / 512;
        for (int it = gw; it < 2 * CITEMS; it += NGW) {
            const bool isv = it >= CITEMS; const int r = isv ? it - CITEMS : it;
            const float* src = (isv ? cache_v : cache_k) + (size_t)r * 512 + F.lane * 8;
            bf16* dst = (bf16*)(a.ws + (isv ? WS_CVB : WS_CKB)) + (size_t)r * 512 + F.lane * 8;
            const f32x4 x0 = *(const f32x4*)src, x1 = *(const f32x4*)(src + 4);
            v4u o; o.x = pk2(x0[0], x0[1]); o.y = pk2(x0[2], x0[3]); o.z = pk2(x1[0], x1[1]); o.w = pk2(x1[2], x1[3]);
            *(v4u*)dst = o;
        }
    }
}

__device__ __forceinline__ void phase_p0b(Frame& F, const Args& a) {
    const float* mod = (const float*)(a.ws + WS_MOD); const float* norm_g = a.in[6];
    float* GS = (float*)(a.ws + WS_GS); float* BIAS = (float*)(a.ws + WS_BIAS); float* ssp = (float*)(a.ws + WS_SSP);
    bf16* XS = (bf16*)(a.ws + WS_XS);
    const int gw = F.vcu * NWAVES + F.wave, NGW = F.G * NWAVES;
    for (int i = (blockIdx.x * NTHR + F.tid); i < DEPTH * NMG * D; i += F.G * NTHR) { const int layer = i / (NMG * D), mg = (i / D) % NMG, k = i % D;
        GS[i] = norm_g[layer * D + k] * (1.0f + mod[((size_t)mg * DEPTH + layer) * 3 * D + D + k]); }
    for (int t = gw; t < NTOK; t += NGW) {
        const float* xr = t < NCTX ? a.in[0] + (size_t)t * D : a.in[1] + (size_t)(t - NCTX) * D;
        const int mg = t < NCTX ? 0 : 1 + (t - NCTX) / LSEQ;
        const float* sc = mod + ((size_t)mg * DEPTH + 0) * 3 * D + D; const float* ng = norm_g;
        float s = 0.f;
#pragma unroll
        for (int jj = 0; jj < 4; ++jj) { const int k = jj * 256 + F.lane * 4; const f32x4 v = *(const f32x4*)(xr + k); const f32x4 g4 = *(const f32x4*)(ng + k); const f32x4 s4 = *(const f32x4*)(sc + k);
            s += (v[0] * v[0] + v[1] * v[1]) + (v[2] * v[2] + v[3] * v[3]);
            const f32x4 o = v * g4 * (s4 + 1.0f);
            unsigned long long w = (unsigned long long)pk2(o[0], o[1]) | ((unsigned long long)pk2(o[2], o[3]) << 32);
            *(unsigned long long*)(XS + (size_t)t * D + k) = w; }
        s = wave_sum(s);
        if (F.lane < 16) ssp[(size_t)t * 16 + F.lane] = F.lane == 0 ? s : 0.f;
    }
    {
        LAS float* sh = (LAS float*)F.lds;
        int cur_layer = -1;
        for (int it = blockIdx.x; it < 224; it += F.G) {
            int layer, chunk; if (it < 48) { layer = 0; chunk = it; } else if (it < 112) { layer = 1; chunk = it - 48; } else if (it < 160) { layer = 2; chunk = it - 112; } else { layer = 3; chunk = it - 160; }
            if (layer != cur_layer) { __syncthreads();
                for (int i = F.tid; i < NMG * D; i += NTHR) sh[i] = mod[((size_t)(i >> 10) * DEPTH + layer) * 3 * D + (i & 1023)];
                cur_layer = layer; __syncthreads(); }
            const bf16* WT = (layer & 1) ? (const bf16*)(a.ws + WS_WNI) + (size_t)(layer >> 1) * 4096 * D : (const bf16*)(a.ws + WS_WCI) + (size_t)(layer >> 1) * 3072 * D;
            for (int rr = 0; rr < 8; ++rr) { const int n = chunk * 64 + F.wave * 8 + rr;
                const v4u w0 = *(const v4u*)(WT + (size_t)n * D + F.lane * 16), w1 = *(const v4u*)(WT + (size_t)n * D + F.lane * 16 + 8);
                float wf[16] = {bflo(w0.x), bfhi(w0.x), bflo(w0.y), bfhi(w0.y), bflo(w0.z), bfhi(w0.z), bflo(w0.w), bfhi(w0.w),
                                bflo(w1.x), bfhi(w1.x), bflo(w1.y), bfhi(w1.y), bflo(w1.z), bfhi(w1.z), bflo(w1.w), bfhi(w1.w)};
#pragma unroll
                for (int v = 0; v < NMG; ++v) { float s = 0.f;
#pragma unroll
                    for (int q = 0; q < 16; ++q) s += wf[q] * sh[v * D + F.lane * 16 + q];
                    s = wave_sum(s);
                    if (F.lane == 0) BIAS[((size_t)layer * NMG + v) * 4096 + n] = s; } }
        }
    }
}


constexpr int CONV_TT = 16, CONV_ROWS = CONV_TT + CK - 1;
__device__ __forceinline__ void phase_conv(Frame& F, const Args& a, int j) {
    const bf16* U = (const bf16*)(a.ws + WS_B0); const bf16* SZ = (const bf16*)(a.ws + WS_B1); bf16* Gb = (bf16*)(a.ws + WS_G);
    const float* dw_w = a.in[10] + (size_t)j * CK * D; const float* dw_b = a.in[11] + j * D; const float* ln_g = a.in[12] + j * D; const float* ln_b = a.in[13] + j * D;
    const int tid = opaque(F.tid), lane = tid & 63;
    typedef float f32x2 __attribute__((ext_vector_type(2)));
    f32x2 w[CK];
#pragma unroll
    for (int k = 0; k < CK; ++k) w[k] = *(const f32x2*)(dw_w + k * D + 2 * tid);
    const f32x2 cb = *(const f32x2*)(dw_b + 2 * tid), lg = *(const f32x2*)(ln_g + 2 * tid), lb = *(const f32x2*)(ln_b + 2 * tid);
    LAS unsigned char* rows = F.lds;
    LAS float* red = (LAS float*)(F.lds + CONV_ROWS * 2048);
    LAS float* stats = red + 256;
    for (int item = blockIdx.x; item < NTOK / CONV_TT; item += F.G) {
        const int t0 = item * CONV_TT;
        int s0, len; if (t0 < NCTX) { s0 = (t0 / SEQ) * SEQ; len = SEQ; } else { s0 = NCTX + ((t0 - NCTX) / LSEQ) * LSEQ; len = LSEQ; }
        for (int q = tid; q < CONV_ROWS * 128; q += NTHR) { const int row = q >> 7, ch = q & 127; const int tok = t0 - (CK / 2) + row;
            v4u v = {0u, 0u, 0u, 0u};
            if (tok >= s0 && tok < s0 + len) v = *(const v4u*)(U + (size_t)tok * D + ch * 8);
            *(LAS v4u*)(rows + row * 2048 + ch * 16) = v; }
        unsigned szw[CONV_TT];
#pragma unroll
        for (int l = 0; l < CONV_TT; ++l) szw[l] = *(const unsigned*)(SZ + (size_t)(t0 + l) * D + 2 * tid);
        __syncthreads();
        float o0[CONV_TT], o1[CONV_TT];
#pragma unroll
        for (int l = 0; l < CONV_TT; ++l) { o0[l] = cb.x; o1[l] = cb.y; }
#pragma unroll
        for (int r = 0; r < CONV_ROWS; ++r) { const unsigned uw = *(const LAS unsigned*)(rows + r * 2048 + tid * 4); const float u0 = bflo(uw), u1 = bfhi(uw);
#pragma unroll
            for (int l = 0; l < CONV_TT; ++l) { const int k = r - l; if (k >= 0 && k < CK) { o0[l] += u0 * w[k].x; o1[l] += u1 * w[k].y; } }
            if ((r & 3) == 3) asm volatile("" ::: "memory"); }
        float v[32];
#pragma unroll
        for (int l = 0; l < CONV_TT; ++l) { v[l] = o0[l] + o1[l]; v[16 + l] = o0[l] * o0[l] + o1[l] * o1[l]; }
#pragma unroll
        for (int s = 0; s < 5; ++s) { const int hn = 16 >> s; const unsigned upm = 0u - ((unsigned)(lane >> s) & 1u);
#pragma unroll
            for (int i = 0; i < hn; ++i) { const unsigned a_ = __float_as_uint(v[i]), b_ = __float_as_uint(v[i + hn]);
                const float keep = __uint_as_float((b_ & upm) | (a_ & ~upm)), send = __uint_as_float((a_ & upm) | (b_ & ~upm)); v[i] = keep + __shfl_xor(send, 1 << s); } }
        v[0] += __shfl_xor(v[0], 32);
        if (lane < 32) { const int idx = ((lane & 1) << 4) | ((lane & 2) << 2) | (lane & 4) | ((lane & 8) >> 2) | ((lane & 16) >> 4); red[F.wave * 32 + idx] = v[0]; }
        __syncthreads();
        if (tid < 32) { float s = 0.f;
#pragma unroll
            for (int w8 = 0; w8 < 8; ++w8) s += red[w8 * 32 + tid];
            stats[tid] = s; }
        __syncthreads();
#pragma unroll
        for (int l = 0; l < CONV_TT; ++l) { const float mu = stats[l] * (1.0f / D); const float var = stats[16 + l] * (1.0f / D) - mu * mu; const float rstd = __builtin_amdgcn_rsqf(var + EPS);
            const float y0 = (o0[l] - mu) * rstd * lg.x + lb.x, y1 = (o1[l] - mu) * rstd * lg.y + lb.y;
            *(unsigned*)(Gb + (size_t)(t0 + l) * D + 2 * tid) = pk2(silu_f(y0) * bflo(szw[l]), silu_f(y1) * bfhi(szw[l])); }
    }
    __syncthreads();
}

namespace att {
typedef float f32x16 __attribute__((ext_vector_type(16)));
typedef short s16x4 __attribute__((ext_vector_type(4)));
constexpr int SLOT = 16384, KOFF = 0, VOFF = 8192, TBL_OFF = 32768, WSF_OFF = 34816;
constexpr float THR = 8.0f, NEG = -1.0e30f;
__device__ __forceinline__ int crow(int r, int hi) { return (r & 3) + 8 * (r >> 2) + 4 * hi; }
__device__ __forceinline__ unsigned cvtpk(float lo, float hi) { unsigned r; asm volatile("v_cvt_pk_bf16_f32 %0, %1, %2" : "=v"(r) : "v"(lo), "v"(hi)); return r; }
__device__ __forceinline__ s16x4 vtr(const LAS unsigned char* p) { return __builtin_bit_cast(s16x4, __builtin_amdgcn_ds_read_tr16_b64_v4i16((LAS s16x4*)p)); }
__device__ __forceinline__ float swapmax(float m) { auto rr = __builtin_amdgcn_permlane32_swap(__float_as_uint(m), __float_as_uint(m), false, false); return fmaxf(__uint_as_float(rr[0]), __uint_as_float(rr[1])); }
__device__ __forceinline__ float swapadd(float m) { auto rr = __builtin_amdgcn_permlane32_swap(__float_as_uint(m), __float_as_uint(m), false, false); return __uint_as_float(rr[0]) + __uint_as_float(rr[1]); }
struct Params { const bf16 *Q, *K, *V, *SZ, *CK, *CV; bf16* G; const float* rpb; int j; };

template <int NP> __device__ __forceinline__ void softmax_step(f32x16 (&p)[2], float& m, float& l, f32x16 (&o)[2], LAS float* wsf, int r32, int hi) {
    float rm = p[0][0];
#pragma unroll
    for (int r = 1; r < 16; ++r) rm = fmaxf(rm, p[0][r]);
    if (NP == 2) {
#pragma unroll
        for (int r = 0; r < 16; ++r) rm = fmaxf(rm, p[1][r]); }
    rm = swapmax(rm);
    if (__any(rm > m + THR)) {
        const float mn = fmaxf(m, rm); const float alpha = __builtin_amdgcn_exp2f(m - mn); m = mn; l *= alpha;
        if (hi == 0) wsf[r32] = alpha;
#pragma unroll
        for (int r = 0; r < 16; ++r) { const float al = wsf[crow(r, hi)]; o[0][r] *= al; o[1][r] *= al; }
    }
    float s = 0.f;
#pragma unroll
    for (int r = 0; r < 16; ++r) { p[0][r] = __builtin_amdgcn_exp2f(p[0][r] - m); s += p[0][r]; }
    if (NP == 2) {
#pragma unroll
        for (int r = 0; r < 16; ++r) { p[1][r] = __builtin_amdgcn_exp2f(p[1][r] - m); s += p[1][r]; } }
    l += s;
}
__device__ __forceinline__ bf16x8 packp(const f32x16& p, int s8) {
    v4u w; w.x = cvtpk(p[s8 + 0], p[s8 + 1]); w.y = cvtpk(p[s8 + 2], p[s8 + 3]); w.z = cvtpk(p[s8 + 4], p[s8 + 5]); w.w = cvtpk(p[s8 + 6], p[s8 + 7]);
    return __builtin_bit_cast(bf16x8, w);
}

__device__ __forceinline__ void attn_unit(Frame& F, const Params& P, int u) {
    const int tid = opaque(F.tid), lane = tid & 63, wid = F.wave, r32 = lane & 31, hi = lane >> 5;
    LAS unsigned char* lds = F.lds;
    LAS float* tbl = (LAS float*)(lds + TBL_OFF);
    LAS float* wsf = (LAS float*)(lds + WSF_OFF) + wid * 32;
    const bool is_na = u < 512;
    int b, h, ntiles, rlo = 0, r0 = 0;
    if (is_na) { b = u >> 7; h = (u >> 3) & 15; r0 = 4 * (u & 7); rlo = r0 - 4; rlo = rlo < 0 ? 0 : rlo; int rh = r0 - 1; rh = rh < 0 ? 0 : (rh > 24 ? 24 : rh); ntiles = 8 + (rh + 7 - rlo + 1); }
    else { const int uu = u - 512; b = uu >> 4; h = uu & 15; ntiles = 4; }
    int tq, rq = 0, cq = 0, bs = 0;
    if (is_na) { const int jb = wid >> 1; rq = r0 + 2 * (wid & 1) + (r32 >> 4); cq = 16 * jb + (r32 & 15); tq = NCTX + b * LSEQ + rq * GWID + cq; bs = jb == 0 ? 0 : (jb == 1 ? 8 : (jb == 2 ? 24 : 32)); }
    else tq = b * SEQ + wid * 32 + r32;
    int rsq = rq - 4; rsq = rsq < 0 ? 0 : (rsq > 24 ? 24 : rsq);
    int qs = cq - 8; qs = qs < 0 ? 0 : (qs > 48 ? 48 : qs);
    const int srow = tid >> 3, sch = tid & 7;
    const unsigned kst = sch * 1024 + srow * 16, vst = VOFF + (sch >> 2) * 4096 + (srow >> 3) * 512 + (srow & 7) * 64 + (sch & 3) * 16;
    const size_t lane_off = (size_t)srow * D + h * DH + sch * 8;
    v4u rk, rv;
#define ATT_TILE_PTRS(t, kp, vp) do { if (is_na && (t) < 8) { const size_t o_ = ((size_t)(b * 2 + P.j) * PAST + 64 * (t)) * D + lane_off; kp = P.CK + o_; vp = P.CV + o_; } \
        else { const size_t o_ = (is_na ? (size_t)(NCTX + b * LSEQ + (rlo + (t) - 8) * GWID) : (size_t)(b * SEQ + 64 * (t))) * D + lane_off; kp = P.K + o_; vp = P.V + o_; } } while (0)
    { const bf16 *kp, *vp; ATT_TILE_PTRS(0, kp, vp); rk = *(const v4u*)kp; rv = *(const v4u*)vp; }
    if (is_na) { for (int i = tid; i < 15 * 31; i += NTHR) tbl[i] = P.rpb[((size_t)P.j * NH + h) * 465 + i] * LOG2E_F; }
    bf16x8 qr[4];
#pragma unroll
    for (int d0 = 0; d0 < 4; ++d0) qr[d0] = *(const bf16x8*)(P.Q + (size_t)tq * D + h * DH + d0 * 16 + hi * 8);
    *(LAS v4u*)(lds + kst) = rk; *(LAS v4u*)(lds + vst) = rv;
    __syncthreads();
    float m = NEG, l = 0.f; f32x16 o[2];
#pragma unroll
    for (int r = 0; r < 16; ++r) { o[0][r] = 0.f; o[1][r] = 0.f; }
    const unsigned vrd = VOFF + ((lane >> 4) & 1) * 32 + (lane & 3) * 8 + (4 * hi + ((lane & 15) >> 2)) * 64;
    for (int t = 0; t < ntiles; ++t) {
        if (t + 1 < ntiles) { const bf16 *kp, *vp; ATT_TILE_PTRS(t + 1, kp, vp); rk = *(const v4u*)kp; rv = *(const v4u*)vp; }
        const LAS unsigned char* slot = lds + (t & 1) * SLOT;
        f32x16 p[2];
#pragma unroll
        for (int r = 0; r < 16; ++r) { p[0][r] = 0.f; p[1][r] = 0.f; }
        if (!is_na || t < 8) {
            const LAS unsigned char* kb = slot + hi * 1024 + r32 * 16;
#pragma unroll
            for (int d0 = 0; d0 < 4; ++d0) { const bf16x8 k0 = *(const LAS bf16x8*)(kb + d0 * 2048), k1 = *(const LAS bf16x8*)(kb + d0 * 2048 + 512);
                p[0] = __builtin_amdgcn_mfma_f32_32x32x16_bf16(k0, qr[d0], p[0], 0, 0, 0); p[1] = __builtin_amdgcn_mfma_f32_32x32x16_bf16(k1, qr[d0], p[1], 0, 0, 0); }
            softmax_step<2>(p, m, l, o, wsf, r32, hi);
            const bf16x8 pa0 = packp(p[0], 0), pa1 = packp(p[0], 8), pa2 = packp(p[1], 0), pa3 = packp(p[1], 8);
            const LAS unsigned char* vb = slot + vrd;
#pragma unroll
            for (int d0 = 0; d0 < 2; ++d0) {
#pragma unroll
                for (int ks = 0; ks < 4; ++ks) { const s16x4 lo = vtr(vb + d0 * 4096 + ks * 1024), h4 = vtr(vb + d0 * 4096 + ks * 1024 + 512);
                    const bf16x8 vf = (bf16x8){lo[0], lo[1], lo[2], lo[3], h4[0], h4[1], h4[2], h4[3]};
                    o[d0] = __builtin_amdgcn_mfma_f32_32x32x16_bf16(ks == 0 ? pa0 : (ks == 1 ? pa1 : (ks == 2 ? pa2 : pa3)), vf, o[d0], 0, 0, 0); } }
        } else {
            const int rr = rlo + t - 8;
            const LAS unsigned char* kb = slot + hi * 1024 + (bs + r32) * 16;
#pragma unroll
            for (int d0 = 0; d0 < 4; ++d0) { const bf16x8 k0 = *(const LAS bf16x8*)(kb + d0 * 2048); p[0] = __builtin_amdgcn_mfma_f32_32x32x16_bf16(k0, qr[d0], p[0], 0, 0, 0); }
            const bool rowok = rr >= rsq && rr < rsq + 8;
            const int tb = (rr - rq + 7) * 31 - cq + 15;
#pragma unroll
            for (int r = 0; r < 16; ++r) { const int kc = bs + crow(r, hi); const bool ok = rowok && kc >= qs && kc < qs + 16; const float bias = tbl[ok ? tb + kc : 0]; p[0][r] = ok ? p[0][r] + bias : NEG; }
            softmax_step<1>(p, m, l, o, wsf, r32, hi);
            const bf16x8 pa0 = packp(p[0], 0), pa1 = packp(p[0], 8);
            const LAS unsigned char* vb = slot + vrd + (bs >> 3) * 512;
#pragma unroll
            for (int d0 = 0; d0 < 2; ++d0) {
#pragma unroll
                for (int ks = 0; ks < 2; ++ks) { const s16x4 lo = vtr(vb + d0 * 4096 + ks * 1024), h4 = vtr(vb + d0 * 4096 + ks * 1024 + 512);
                    const bf16x8 vf = (bf16x8){lo[0], lo[1], lo[2], lo[3], h4[0], h4[1], h4[2], h4[3]};
                    o[d0] = __builtin_amdgcn_mfma_f32_32x32x16_bf16(ks == 0 ? pa0 : pa1, vf, o[d0], 0, 0, 0); } }
        }
        if (t + 1 < ntiles) { LAS unsigned char* nslot = lds + ((t + 1) & 1) * SLOT; *(LAS v4u*)(nslot + kst) = rk; *(LAS v4u*)(nslot + vst) = rv; }
        __syncthreads();
    }
#undef ATT_TILE_PTRS
    l = swapadd(l);
    if (hi == 0) wsf[r32] = __builtin_amdgcn_rcpf(l);
    const int tq0 = tq - r32;
#pragma unroll
    for (int r = 0; r < 16; ++r) { const int qi = crow(r, hi); const float rl = wsf[qi];
        int tok; if (is_na) tok = NCTX + b * LSEQ + (r0 + 2 * (wid & 1) + (qi >> 4)) * GWID + 16 * (wid >> 1) + (qi & 15); else tok = tq0 + qi;
#pragma unroll
        for (int d0 = 0; d0 < 2; ++d0) { const size_t idx = (size_t)tok * D + h * DH + d0 * 32 + r32;
            P.G[idx] = (bf16)f2bf(o[d0][r] * rl * bf2f(P.SZ[idx])); } }
    __syncthreads();
}
}
__device__ __forceinline__ void phase_attn(Frame& F, const Args& a, int j) {
    att::Params P{(const bf16*)(a.ws + WS_B0), (const bf16*)(a.ws + WS_B2), (const bf16*)(a.ws + WS_B3), (const bf16*)(a.ws + WS_B1), (const bf16*)(a.ws + WS_CKB), (const bf16*)(a.ws + WS_CVB),
                  (bf16*)(a.ws + WS_G), a.in[16], j};
    for (int u = F.vcu; u < 768; u += F.G) att::attn_unit(F, P, u);
}

__device__ __forceinline__ void phase_final(Frame& F, const Args& a) {
    const float* ssp = (const float*)(a.ws + WS_SSP); const float* fg = a.in[18];
    const int gw = F.vcu * NWAVES + F.wave, NGW = F.G * NWAVES;
    for (int t = gw; t < NTOK; t += NGW) {
        const float rs = pg8::row_rscale(ssp, t);
        float* xr = a.out + (size_t)t * D;
#pragma unroll
        for (int jj = 0; jj < 4; ++jj) { const int k = jj * 256 + F.lane * 4; f32x4 v = *(const f32x4*)(xr + k); const f32x4 g4 = *(const f32x4*)(fg + k);
            *(f32x4*)(xr + k) = v * rs * g4; }
    }
}

#ifndef MK_ONE_LAUNCH
#define MK_ONE_LAUNCH 1
#endif
constexpr int N_PHASES = 15;
__global__ void __launch_bounds__(NTHR, 2) mk_fwd(Args args) {
    extern __shared__ __attribute__((aligned(16))) unsigned char lds[];
    Frame F;
    F.lds = (LAS unsigned char*)lds;
    F.MISC = (volatile LAS unsigned*)(F.lds + MISC_OFF);
    F.tid = threadIdx.x; asm volatile("" : "+v"(F.tid)); F.lane = F.tid & 63; F.wave = __builtin_amdgcn_readfirstlane(F.tid >> 6);
    F.G = gridDim.x; { const int bx = blockIdx.x; F.vcu = (F.G % 8 == 0) ? (bx % 8) * (F.G / 8) + bx / 8 : bx; }
    unsigned char* ws = args.ws;
    F.ctl = (gu32*)(ws + WS_CTL);
    const int lo = args.ph_lo, hi = args.ph_hi;
#define IN(k) (lo <= (k) && (k) < hi)
    for (int u = F.tid; u < (LDS_BYTES - LDSCTL_OFF) / 4; u += NTHR) ((LAS unsigned*)(F.lds + LDSCTL_OFF))[u] = 0u;
    __syncthreads();
    XcdBarrier bar = xcd_barrier_post((unsigned*)(F.ctl + CW_BAR), F.MISC + 8);
#define BOTH(k) (IN(k) && IN((k) + 1))
#define SEAM(k) do { if (BOTH(k)) xcd_barrier(bar); } while (0)
    if (IN(0)) { phase_p0a(F, args); SEAM(0); }
    if (IN(1)) { phase_p0b(F, args); SEAM(1); }
    bf16* XS = (bf16*)(ws + WS_XS); bf16* G = (bf16*)(ws + WS_G); bf16* B0 = (bf16*)(ws + WS_B0); bf16* B1 = (bf16*)(ws + WS_B1); bf16* B2 = (bf16*)(ws + WS_B2); bf16* B3 = (bf16*)(ws + WS_B3);
    float* ssp = (float*)(ws + WS_SSP); const float* mod = (const float*)(ws + WS_MOD);
    float* x = args.out; float* newk = args.out + (size_t)NTOK * D; float* newv = newk + (size_t)NCTX_B * 2 * SEQ * D;
#pragma unroll 1
    for (int layer = 0; layer < DEPTH; ++layer) {
        const int j = layer >> 1;
        const float* bias = (const float*)(ws + WS_BIAS) + (size_t)layer * NMG * 4096;
        if (IN(2 + 3 * layer)) {
            if ((layer & 1) == 0) {
                pg8::Gemm g{XS, (const bf16*)(ws + WS_WCI) + (size_t)j * 3072 * D, NTOK, 3072, D}; pg8::StaticOrder S; S.init(NTOK, 3072, F.G, (int)blockIdx.x);
                pg8::EpiConv1 E{ssp, bias, B0, B1};
                pg8::gemm_phase<pg8::EpiConv1, pg8::StaticOrder, true, true>(F.lds + RING_OFF, g, S, E);
            } else {
                pg8::Gemm g{XS, (const bf16*)(ws + WS_WNI) + (size_t)j * 4096 * D, NTOK, 4096, D}; pg8::StaticOrder S; S.init(NTOK, 4096, F.G, (int)blockIdx.x);
                pg8::EpiAttn1 E{ssp, bias, B0, (size_t)(WS_B1 - WS_B0) / 2, newk, (size_t)NCTX_B * 2 * SEQ * D, j};
                pg8::gemm_phase<pg8::EpiAttn1, pg8::StaticOrder, true, true>(F.lds + RING_OFF, g, S, E);
            }
            SEAM(2 + 3 * layer);
        }
        if (IN(3 + 3 * layer)) {
#ifndef NO_CONV
            if ((layer & 1) == 0) phase_conv(F, args, j);
#endif
#ifndef NO_ATTN
            if ((layer & 1) == 1) phase_attn(F, args, j);
#endif
            SEAM(3 + 3 * layer);
        }
        if (IN(4 + 3 * layer)) {
            const bf16* WT = (layer & 1) ? (const bf16*)(ws + WS_WNO) + (size_t)j * D * D : (const bf16*)(ws + WS_WCO) + (size_t)j * D * D;
            pg8::Gemm g{G, WT, NTOK, D, D}; pg8::StaticOrder S; S.init(NTOK, D, F.G, (int)blockIdx.x);
            const float* bc = layer == 0 ? args.in[0] : x; const float* bl = layer == 0 ? args.in[1] : x + (size_t)NCTX * D;
            const float* gate = mod + (size_t)layer * 3 * D + 2 * D;
            if (layer < DEPTH - 1) {
                pg8::EpiGemm2<true> E{bc, bl, x, gate, DEPTH * 3 * D, (const float*)(ws + WS_GS) + (size_t)(layer + 1) * NMG * D, XS, ssp};
                pg8::gemm_phase<pg8::EpiGemm2<true>, pg8::StaticOrder, true, true>(F.lds + RING_OFF, g, S, E);
            } else {
                pg8::EpiGemm2<false> E{bc, bl, x, gate, DEPTH * 3 * D, nullptr, XS, ssp};
                pg8::gemm_phase<pg8::EpiGemm2<false>, pg8::StaticOrder, true, true>(F.lds + RING_OFF, g, S, E);
            }
            SEAM(4 + 3 * layer);
        }
    }
    if (IN(14)) phase_final(F, args);
#undef IN
#undef BOTH
#undef SEAM
}

__global__ void __launch_bounds__(256) k_conv_b(const bf16* __restrict__ U, const bf16* __restrict__ SZ, const float* __restrict__ dw_w, const float* __restrict__ dw_b,
                                                 const float* __restrict__ ln_g, const float* __restrict__ ln_b, bf16* __restrict__ Gb) {
    const int t = blockIdx.x;
    int s0, len;
    if (t < NCTX) { s0 = (t / SEQ) * SEQ; len = SEQ; } else { s0 = NCTX + ((t - NCTX) / LSEQ) * LSEQ; len = LSEQ; }
    const int l = t - s0;
    float v[4]; float s = 0.f;
#pragma unroll
    for (int i = 0; i < 4; ++i) {
        int c = threadIdx.x + i * 256;
        float acc = dw_b[c];
        for (int k = 0; k < CK; ++k) { int ll = l + k - CK / 2; if (ll >= 0 && ll < len) acc += bf2f(U[(size_t)(s0 + ll) * D + c]) * dw_w[k * D + c]; }
        v[i] = acc; s += acc;
    }
    __shared__ float red[256];
    red[threadIdx.x] = s; __syncthreads();
    for (int o = 128; o > 0; o >>= 1) { if (threadIdx.x < o) red[threadIdx.x] += red[threadIdx.x + o]; __syncthreads(); }
    const float mu = red[0] / D; __syncthreads();
    float q = 0.f;
#pragma unroll
    for (int i = 0; i < 4; ++i) { float d = v[i] - mu; q += d * d; }
    red[threadIdx.x] = q; __syncthreads();
    for (int o = 128; o > 0; o >>= 1) { if (threadIdx.x < o) red[threadIdx.x] += red[threadIdx.x + o]; __syncthreads(); }
    const float rstd = rsqrtf(red[0] / D + EPS);
#pragma unroll
    for (int i = 0; i < 4; ++i) { int c = threadIdx.x + i * 256; float u = (v[i] - mu) * rstd * ln_g[c] + ln_b[c];
        Gb[(size_t)t * D + c] = (bf16)f2bf(silu_f(u) * bf2f(SZ[(size_t)t * D + c])); }
}

__global__ void __launch_bounds__(256) k_ctx_attn_b(const bf16* __restrict__ Q, const bf16* __restrict__ K, const bf16* __restrict__ V, const bf16* __restrict__ SZ, bf16* __restrict__ Gb) {
    const int t = blockIdx.x, h = blockIdx.y, b = t / SEQ;
    __shared__ float sq[DH]; __shared__ float sp[SEQ]; __shared__ float red[256];
    if (threadIdx.x < DH) sq[threadIdx.x] = bf2f(Q[(size_t)t * D + h * DH + threadIdx.x]);
    __syncthreads();
    const int l = threadIdx.x;
    const bf16* kr = K + (size_t)(b * SEQ + l) * D + h * DH;
    float sc = 0.f;
    for (int d = 0; d < DH; ++d) sc += sq[d] * bf2f(kr[d]);
    red[threadIdx.x] = sc; __syncthreads();
    for (int o = 128; o > 0; o >>= 1) { if (threadIdx.x < o) red[threadIdx.x] = fmaxf(red[threadIdx.x], red[threadIdx.x + o]); __syncthreads(); }
    const float mx = red[0]; __syncthreads();
    const float p = exp2f(sc - mx);
    sp[l] = p; red[threadIdx.x] = p; __syncthreads();
    for (int o = 128; o > 0; o >>= 1) { if (threadIdx.x < o) red[threadIdx.x] += red[threadIdx.x + o]; __syncthreads(); }
    const float inv = 1.f / red[0];
    if (threadIdx.x < DH) { const int d = threadIdx.x; float o = 0.f;
        for (int ll = 0; ll < SEQ; ++ll) o += sp[ll] * bf2f(V[(size_t)(b * SEQ + ll) * D + h * DH + d]);
        const size_t idx = (size_t)t * D + h * DH + d;
        Gb[idx] = (bf16)f2bf(o * inv * bf2f(SZ[idx])); }
}

__global__ void __launch_bounds__(256) k_na_attn_b(const bf16* __restrict__ Q, const bf16* __restrict__ K, const bf16* __restrict__ V, const bf16* __restrict__ SZ,
                                                    const bf16* __restrict__ CKb, const bf16* __restrict__ CVb, const float* __restrict__ rpb, int j, bf16* __restrict__ Gb) {
    const int tl = blockIdx.x, h = blockIdx.y;
    const int b = tl / LSEQ, n = tl % LSEQ, r = n / GWID, c = n % GWID;
    const int t = NCTX + tl;
    __shared__ float sq[DH]; __shared__ float sp[128 + PAST]; __shared__ float red[256];
    if (threadIdx.x < DH) sq[threadIdx.x] = bf2f(Q[(size_t)t * D + h * DH + threadIdx.x]);
    __syncthreads();
    int rs = r - 4; rs = rs < 0 ? 0 : (rs > 24 ? 24 : rs);
    int qs = c - 8; qs = qs < 0 ? 0 : (qs > 48 ? 48 : qs);
    const bf16* ck = CKb + ((size_t)(b * 2 + j) * PAST) * D + h * DH;
    const bf16* cv = CVb + ((size_t)(b * 2 + j) * PAST) * D + h * DH;
    const float* rp = rpb + ((size_t)j * NH + h) * 15 * 31;
    float mx = -3.0e38f;
    for (int i = threadIdx.x; i < 128 + PAST; i += 256) {
        float sc = 0.f;
        if (i < 128) { int rr = rs + i / 16, kc = qs + i % 16;
            const bf16* kr = K + (size_t)(NCTX + b * LSEQ + rr * GWID + kc) * D + h * DH;
            for (int d = 0; d < DH; ++d) sc += sq[d] * bf2f(kr[d]);
            int dr = rr - r + 7, dc = kc - c + 15; dc = dc < 0 ? 0 : (dc > 30 ? 30 : dc);
            sc += rp[dr * 31 + dc] * LOG2E_F;
        } else { const bf16* kr = ck + (size_t)(i - 128) * D; for (int d = 0; d < DH; ++d) sc += sq[d] * bf2f(kr[d]); }
        sp[i] = sc; mx = fmaxf(mx, sc);
    }
    red[threadIdx.x] = mx; __syncthreads();
    for (int o = 128; o > 0; o >>= 1) { if (threadIdx.x < o) red[threadIdx.x] = fmaxf(red[threadIdx.x], red[threadIdx.x + o]); __syncthreads(); }
    mx = red[0]; __syncthreads();
    float ps = 0.f;
    for (int i = threadIdx.x; i < 128 + PAST; i += 256) { float p = exp2f(sp[i] - mx); sp[i] = p; ps += p; }
    red[threadIdx.x] = ps; __syncthreads();
    for (int o = 128; o > 0; o >>= 1) { if (threadIdx.x < o) red[threadIdx.x] += red[threadIdx.x + o]; __syncthreads(); }
    const float inv = 1.f / red[0];
    if (threadIdx.x < DH) { const int d = threadIdx.x; float o = 0.f;
        for (int i = 0; i < 128; ++i) { int rr = rs + i / 16, kc = qs + i % 16; o += sp[i] * bf2f(V[(size_t)(NCTX + b * LSEQ + rr * GWID + kc) * D + h * DH + d]); }
        for (int i = 0; i < PAST; ++i) o += sp[128 + i] * bf2f(cv[(size_t)i * D + d]);
        const size_t idx = (size_t)t * D + h * DH + d;
        Gb[idx] = (bf16)f2bf(o * inv * bf2f(SZ[idx])); }
}

extern "C" void kernel_launch(void* const* d_in, const int* in_sizes, int n_in, void* d_out, int out_size, void* d_ws, size_t ws_size, hipStream_t stream) {
    static int grid = 0;
    if (grid == 0) {
        int dev = 0, cus = 0, per_cu = 0;
        if (n_in != 19 || ws_size < WS_END) { fprintf(stderr, "kernel_launch: unexpected n_in %d / ws %zu\n", n_in, ws_size); grid = -1; return; }
        if (hipGetDevice(&dev) != hipSuccess || hipDeviceGetAttribute(&cus, hipDeviceAttributeMultiprocessorCount, dev) != hipSuccess) { grid = -1; return; }
        if (hipFuncSetAttribute((const void*)mk_fwd, hipFuncAttributeMaxDynamicSharedMemorySize, LDS_BYTES) != hipSuccess) { fprintf(stderr, "kernel_launch: hipFuncSetAttribute failed\n"); grid = -1; return; }
        if (hipOccupancyMaxActiveBlocksPerMultiprocessor(&per_cu, (const void*)mk_fwd, NTHR, LDS_BYTES) != hipSuccess || per_cu < 1) { fprintf(stderr, "kernel_launch: occupancy query says %d\n", per_cu); }
        (void)hipGetLastError();
        grid = cus;
    }
    if (grid < 0) return;
    (void)hipMemsetAsync((char*)d_ws + WS_CTL, 0, CTL_ZERO_BYTES, stream);
    Args a{};
    for (int i = 0; i < 19; ++i) a.in[i] = (const float*)d_in[i];
    a.out = (float*)d_out; a.ws = (unsigned char*)d_ws;
    unsigned char* ws = (unsigned char*)d_ws;
    bf16* G = (bf16*)(ws + WS_G); bf16* B0 = (bf16*)(ws + WS_B0); bf16* B1 = (bf16*)(ws + WS_B1); bf16* B2 = (bf16*)(ws + WS_B2); bf16* B3 = (bf16*)(ws + WS_B3);
    auto run = [&](int lo, int hi) { a.ph_lo = lo; a.ph_hi = hi; hipLaunchKernelGGL(mk_fwd, dim3(grid), dim3(NTHR), LDS_BYTES, stream, a); };
#if MK_ONE_LAUNCH
    run(0, N_PHASES);
#else
    for (int ph = 0; ph < N_PHASES; ++ph) run(ph, ph + 1);
#endif
    (void)G; (void)B0; (void)B1; (void)B2; (void)B3;
}
```

```cpp
#include <hip/hip_runtime.h>
#include <cstdio>
#include <cstdint>
namespace pg8 {
#define PG8_LAS __attribute__((address_space(3)))
typedef unsigned short bf16_t;
typedef short bf16x8 __attribute__((ext_vector_type(8)));
typedef float f32x4 __attribute__((ext_vector_type(4)));
typedef unsigned u32x4 __attribute__((ext_vector_type(4)));
constexpr int BM = 256, BK = 64, HALF = 128, HTB = HALF * BK * 2  , STAGE_BYTES = 8 * HTB, NXCD = 8, WGM = 8;

__host__ __device__ __forceinline__ int lds_byte(int r, int c) { const int st = (r >> 4) * 2 + (c >> 5), rr = r & 15, cc = c & 31, ob = rr * 64 + cc * 2; return st * 1024 + (ob ^ (((ob >> 9) & 1) << 5)); }
__host__ __device__ __forceinline__ void stage_rc(int b, int& R, int& C) { const int st = b / 1024, sb = b % 1024, swz = sb ^ (((sb >> 9) & 1) << 5); R = (st >> 1) * 16 + swz / 64; C = (st & 1) * 32 + (swz % 64) / 2; }
__host__ __device__ __forceinline__ int perm32(int rho) { const int n = rho >> 4, i = rho & 15; return 8 * (i >> 2) + 4 * n + (i & 3); }

struct Unit { int pm, pn; };
struct Gemm { const bf16_t* A; const bf16_t* Bt; int M, N, K; };

struct StaticOrder {
    int nM, nN, nwg, G, c;
    __host__ __device__ void init(int M, int N, int G_, int c_) { nM = M / BM; nN = N / BM; nwg = nM * nN; G = G_; c = c_; }
    __host__ __device__ bool next(int i, Unit& u) const {
        const long L = (long)i * G + c; if (L >= nwg) return false;
        int wgid = (int)L; { const int q = nwg / NXCD, r = nwg % NXCD, xcd = wgid % NXCD, off = wgid / NXCD; wgid = (xcd < r ? xcd * (q + 1) : r * (q + 1) + (xcd - r) * q) + off; }
        const int nig = WGM * nN, gid = wgid / nig, fm = gid * WGM, gsz = (nM - fm) < WGM ? (nM - fm) : WGM;
        u.pm = fm + ((wgid % nig) % gsz); u.pn = (wgid % nig) / gsz; return true;
    }
    __device__ __forceinline__ void a_ready(const Unit&) const {}
    __device__ __forceinline__ void done(const Unit&) const {}
};


__device__ __forceinline__ unsigned cvt_pk_bf16(float lo, float hi) { unsigned r; asm volatile("v_cvt_pk_bf16_f32 %0, %1, %2" : "=v"(r) : "v"(lo), "v"(hi)); return r; }
constexpr int ROWLEN = 1024;
constexpr int NTOKC = 4096;
constexpr float RMS_EPS = 1e-6f;
constexpr float LOG2E = 1.4426950408889634f;
constexpr float QSCALE = 0.125f * LOG2E;
__device__ __forceinline__ int mg_of_tile(int pm) { return pm < 16 ? 0 : 1 + ((pm - 16) >> 3); }
__device__ __forceinline__ float fast_sigmoid(float x) { return __builtin_amdgcn_rcpf(1.0f + __builtin_amdgcn_exp2f(-LOG2E * x)); }
__device__ __forceinline__ f32x4 sigm4(f32x4 v) { return (f32x4){fast_sigmoid(v[0]), fast_sigmoid(v[1]), fast_sigmoid(v[2]), fast_sigmoid(v[3])}; }
__device__ __forceinline__ u32x4 pack8(f32x4 a, f32x4 b) { u32x4 w; w.x = cvt_pk_bf16(a[0], a[1]); w.y = cvt_pk_bf16(a[2], a[3]); w.z = cvt_pk_bf16(b[0], b[1]); w.w = cvt_pk_bf16(b[2], b[3]); return w; }
__device__ __forceinline__ float row_rscale(const float* ssp, int row) {
    const f32x4* p = (const f32x4*)(ssp + (size_t)row * 16);
    const f32x4 a = p[0], b = p[1], c = p[2], d = p[3];
    const f32x4 s = (a + b) + (c + d);
    return __builtin_amdgcn_rsqf(((s[0] + s[1]) + (s[2] + s[3])) * (1.0f / ROWLEN) + RMS_EPS);
}

struct EpiConv1 {
    static constexpr bool PERM = true, AFTER_DRAIN = false;
    const float* ssp; const float* bias  ; bf16_t* U; bf16_t* SZ;
    __device__ __forceinline__ void operator()(const f32x4 (&acc)[2][2][4][2], const Unit& u, int wr, int wc, int fr, int fq) const {
        const int mg = mg_of_tile(u.pm);
        const float* bb = bias + mg * 4096 + u.pn * BM + wc * 32 + 8 * fq;
        f32x4 bv[2][2];
#pragma unroll
        for (int bj = 0; bj < 2; ++bj)
#pragma unroll
            for (int n = 0; n < 2; ++n) bv[bj][n] = *(const f32x4*)(bb + bj * HALF + 4 * n);
        const int row0 = u.pm * BM + wr * 64 + fr;
        if (u.pn < 8) {
            const int col = u.pn * HALF + wc * 32 + 8 * fq;
#pragma unroll
            for (int ai = 0; ai < 2; ++ai)
#pragma unroll
                for (int m = 0; m < 4; ++m) { const int row = row0 + ai * HALF + m * 16; const float rs = row_rscale(ssp, row);
                    const f32x4 a0 = acc[ai][0][m][0] * rs + bv[0][0], a1 = acc[ai][0][m][1] * rs + bv[0][1];
                    const f32x4 b0 = acc[ai][1][m][0] * rs + bv[1][0], b1 = acc[ai][1][m][1] * rs + bv[1][1];
                    *(u32x4*)(U + (size_t)row * ROWLEN + col) = pack8(a0 * sigm4(b0), a1 * sigm4(b1)); }
        } else {
            const int col = (u.pn - 8) * BM + wc * 32 + 8 * fq;
#pragma unroll
            for (int ai = 0; ai < 2; ++ai)
#pragma unroll
                for (int m = 0; m < 4; ++m) { const int row = row0 + ai * HALF + m * 16; const float rs = row_rscale(ssp, row);
#pragma unroll
                    for (int bj = 0; bj < 2; ++bj) { const f32x4 z0 = acc[ai][bj][m][0] * rs + bv[bj][0], z1 = acc[ai][bj][m][1] * rs + bv[bj][1];
                        *(u32x4*)(SZ + (size_t)row * ROWLEN + col + bj * HALF) = pack8(z0 * sigm4(z0), z1 * sigm4(z1)); } }
        }
    }
};

struct EpiAttn1 {
    static constexpr bool PERM = true, AFTER_DRAIN = false;
    const float* ssp; const float* bias; bf16_t* B0; size_t bstride  ; float* newk; size_t nstride  ; int j;
    __device__ __forceinline__ void operator()(const f32x4 (&acc)[2][2][4][2], const Unit& u, int wr, int wc, int fr, int fq) const {
        const int mg = mg_of_tile(u.pm);
        const float* bb = bias + mg * 4096 + u.pn * BM + wc * 32 + 8 * fq;
        f32x4 bv[2][2];
#pragma unroll
        for (int bj = 0; bj < 2; ++bj)
#pragma unroll
            for (int n = 0; n < 2; ++n) bv[bj][n] = *(const f32x4*)(bb + bj * HALF + 4 * n);
        const int row0 = u.pm * BM + wr * 64 + fr;
        const int sect = u.pn >> 2, col = (u.pn & 3) * BM + wc * 32 + 8 * fq;
        const int bidx = sect == 0 ? 0 : (sect == 3 ? 1 : sect + 1);
        bf16_t* dst = B0 + (size_t)bidx * bstride;
        float* cdst = newk + (sect == 2 ? nstride : (size_t)0);
        const bool cache = (sect == 1 || sect == 2) && u.pm < 16;
        const float qs = sect == 0 ? QSCALE : 1.0f;
#pragma unroll
        for (int ai = 0; ai < 2; ++ai)
#pragma unroll
            for (int m = 0; m < 4; ++m) { const int row = row0 + ai * HALF + m * 16; const float rs = row_rscale(ssp, row);
#pragma unroll
                for (int bj = 0; bj < 2; ++bj) { f32x4 v0 = acc[ai][bj][m][0] * rs + bv[bj][0], v1 = acc[ai][bj][m][1] * rs + bv[bj][1];
                    if (cache) { float* cp = cdst + ((size_t)(u.pm * 2 + j) * 256 + (row - u.pm * BM)) * ROWLEN + col + bj * HALF; *(f32x4*)cp = v0; *(f32x4*)(cp + 4) = v1; }
                    v0 = v0 * qs; v1 = v1 * qs;
                    if (sect == 3) { v0 = v0 * sigm4(v0); v1 = v1 * sigm4(v1); }
                    *(u32x4*)(dst + (size_t)row * ROWLEN + col + bj * HALF) = pack8(v0, v1); } }
    }
};

template <bool HAS_NEXT> struct EpiGemm2 {
    static constexpr bool PERM = true, AFTER_DRAIN = false;
    const float* base_ctx; const float* base_lat; float* out; const float* gate  ; int gate_stride; const float* gsn  ; bf16_t* XS; float* ssp;
    __device__ __forceinline__ void operator()(const f32x4 (&acc)[2][2][4][2], const Unit& u, int wr, int wc, int fr, int fq) const {
        const int mg = mg_of_tile(u.pm);
        const int col = u.pn * BM + wc * 32 + 8 * fq;
        f32x4 gv[2][2], sv[2][2];
#pragma unroll
        for (int bj = 0; bj < 2; ++bj)
#pragma unroll
            for (int n = 0; n < 2; ++n) { gv[bj][n] = *(const f32x4*)(gate + (size_t)mg * gate_stride + col + bj * HALF + 4 * n);
                if (HAS_NEXT) sv[bj][n] = *(const f32x4*)(gsn + mg * ROWLEN + col + bj * HALF + 4 * n); }
        const int row0 = u.pm * BM + wr * 64 + fr;
        const float* base = u.pm < 16 ? base_ctx : base_lat - (size_t)NTOKC * ROWLEN;
#pragma unroll
        for (int ai = 0; ai < 2; ++ai)
#pragma unroll
            for (int m = 0; m < 4; ++m) { const int row = row0 + ai * HALF + m * 16; float sq = 0.f;
#pragma unroll
                for (int bj = 0; bj < 2; ++bj) { const size_t off = (size_t)row * ROWLEN + col + bj * HALF;
                    const f32x4 x0 = *(const f32x4*)(base + off) + gv[bj][0] * acc[ai][bj][m][0], x1 = *(const f32x4*)(base + off + 4) + gv[bj][1] * acc[ai][bj][m][1];
                    *(f32x4*)(out + off) = x0; *(f32x4*)(out + off + 4) = x1;
                    sq += (x0[0] * x0[0] + x0[1] * x0[1]) + (x0[2] * x0[2] + x0[3] * x0[3]) + (x1[0] * x1[0] + x1[1] * x1[1]) + (x1[2] * x1[2] + x1[3] * x1[3]);
                    if (HAS_NEXT) *(u32x4*)(XS + off) = pack8(x0 * sv[bj][0], x1 * sv[bj][1]); }
                sq += __shfl_xor(sq, 16); sq += __shfl_xor(sq, 32);
                if (fq == 0) ssp[(size_t)row * 16 + u.pn * 4 + wc] = sq; }
    }
};
template <class Epi, class Sched, bool ALIGN_EPI = false, bool SP2 = false>
__device__ __forceinline__ void gemm_phase(PG8_LAS unsigned char* lds, const Gemm g, const Sched& S, const Epi& E) {
    int tid_ = threadIdx.x; asm volatile("" : "+v"(tid_));
    const int tid = tid_, wid = __builtin_amdgcn_readfirstlane(tid >> 6), lane = tid & 63, wr = wid >> 2, wc = wid & 3, fr = lane & 15, fq = lane >> 4;
    const int K = g.K, nt = K / BK;
    unsigned voffA[2], voffB[2];
#pragma unroll
    for (int i = 0; i < 2; ++i) { int R, C; stage_rc(tid * 16 + i * 8192, R, C); const int Rb = Epi::PERM ? ((R & ~31) + perm32(R & 31)) : R;
        voffA[i] = (unsigned)(R * K + C) * 2u; voffB[i] = (unsigned)(Rb * K + C) * 2u; }
    const size_t kstep = (size_t)(BK * 2);
    const size_t hstep = (size_t)HALF * K * 2;
    const size_t tstep = 2 * hstep;
    const unsigned ldsw = (unsigned)wid * 1024u;
    const int aoff = lds_byte(wr * 64 + fr, fq * 8), boff = lds_byte(wc * 32 + fr, fq * 8);
#define PG8_SA(b, h) (((b) * 2 + (h)) * HTB)
#define PG8_SB(b, h) ((4 + (b) * 2 + (h)) * HTB)
#define PG8_STAGE(bufoff, gbase, voff) do { _Pragma("unroll") for (int _i = 0; _i < 2; ++_i) \
        __builtin_amdgcn_global_load_lds((const unsigned*)((const char*)(gbase) + (voff)[_i]), (PG8_LAS unsigned*)(lds + (bufoff) + ldsw + _i * 8192), 16, 0, 0); } while (0)
#define PG8_LDA(dst, b, h) do { _Pragma("unroll") for (int m = 0; m < 4; ++m) _Pragma("unroll") for (int k = 0; k < 2; ++k) dst[m][k] = *(const PG8_LAS bf16x8*)(lds + PG8_SA(b, h) + aoff + m * 2048 + k * 1024); } while (0)
#define PG8_LDB(dst, b, h) do { _Pragma("unroll") for (int n = 0; n < 2; ++n) _Pragma("unroll") for (int k = 0; k < 2; ++k) dst[n][k] = *(const PG8_LAS bf16x8*)(lds + PG8_SB(b, h) + boff + n * 2048 + k * 1024); } while (0)
#define PG8_MMA(ai, bj, At, Bt) do { __builtin_amdgcn_s_setprio(1); _Pragma("unroll") for (int m = 0; m < 4; ++m) _Pragma("unroll") for (int n = 0; n < 2; ++n) _Pragma("unroll") for (int k = 0; k < 2; ++k) \
        acc[ai][bj][m][n] = __builtin_amdgcn_mfma_f32_16x16x32_bf16(Bt[n][k], At[m][k], acc[ai][bj][m][n], 0, 0, 0); __builtin_amdgcn_s_setprio(0); } while (0)
#define PG8_WAIT_V(n) asm volatile("s_waitcnt vmcnt(" #n ")" ::: "memory")
#define PG8_WAIT_L(n) asm volatile("s_waitcnt lgkmcnt(" #n ")" ::: "memory")
#define PG8_BAR __builtin_amdgcn_s_barrier()
#define PG8_SCHED __builtin_amdgcn_sched_barrier(0)
    Unit cur, nxt; int ui = 0;
    if (!S.next(0, cur)) return;
    f32x4 acc[2][2][4][2];
#pragma unroll
    for (int a = 0; a < 2; ++a)
#pragma unroll
        for (int b = 0; b < 2; ++b)
#pragma unroll
            for (int m = 0; m < 4; ++m)
#pragma unroll
                for (int n = 0; n < 2; ++n) acc[a][b][m][n] = (f32x4){0.f, 0.f, 0.f, 0.f};
    bf16x8 At[4][2], B0[2][2], B1[2][2];
    const char* cA = (const char*)g.A + (size_t)cur.pm * tstep; const char* cB = (const char*)g.Bt + (size_t)cur.pn * tstep;
    S.a_ready(cur);
    if constexpr (SP2) {
        PG8_STAGE(PG8_SB(0, 0), cB, voffB); PG8_STAGE(PG8_SB(0, 1), cB + hstep, voffB); PG8_STAGE(PG8_SA(0, 0), cA, voffA); PG8_STAGE(PG8_SA(0, 1), cA + hstep, voffA);
        if (wr == 1) PG8_BAR;
        PG8_WAIT_V(2); PG8_BAR;
        PG8_STAGE(PG8_SB(1, 0), cB + kstep, voffB); PG8_STAGE(PG8_SA(1, 0), cA + kstep, voffA); PG8_STAGE(PG8_SB(1, 1), cB + hstep + kstep, voffB);
        PG8_WAIT_V(6); PG8_BAR;
    } else {
        PG8_STAGE(PG8_SB(0, 0), cB, voffB); PG8_STAGE(PG8_SA(0, 0), cA, voffA); PG8_STAGE(PG8_SB(0, 1), cB + hstep, voffB); PG8_STAGE(PG8_SA(0, 1), cA + hstep, voffA);
        if (wr == 1) PG8_BAR;
        PG8_WAIT_V(4); PG8_BAR;
        PG8_STAGE(PG8_SB(1, 0), cB + kstep, voffB); PG8_STAGE(PG8_SA(1, 0), cA + kstep, voffA); PG8_STAGE(PG8_SB(1, 1), cB + hstep + kstep, voffB);
        PG8_WAIT_V(6); PG8_BAR;
    }
    for (;;) {
        const bool has_next = S.next(ui + 1, nxt);
        const char* nA = has_next ? (const char*)g.A + (size_t)nxt.pm * tstep : cA; const char* nB = has_next ? (const char*)g.Bt + (size_t)nxt.pn * tstep : cB;
        for (int t = 0; t < nt; t += 2) {
            const bool last = (t == nt - 2);
            const char* a1 = cA + (size_t)(t + 1) * kstep;
            const char* a2 = last ? nA : cA + (size_t)(t + 2) * kstep; const char* b2 = last ? nB : cB + (size_t)(t + 2) * kstep;
            const char* a3 = a2 + kstep; const char* b3 = b2 + kstep;
            if (last && has_next) S.a_ready(nxt);
            if constexpr (SP2) {
            PG8_LDB(B0, 0, 0); PG8_LDB(B1, 0, 1); PG8_SCHED; PG8_LDA(At, 0, 0); PG8_STAGE(PG8_SA(1, 1), a1 + hstep, voffA);
            PG8_WAIT_V(8); PG8_WAIT_L(0); PG8_BAR; PG8_MMA(0, 0, At, B0); PG8_MMA(0, 1, At, B1); PG8_BAR; PG8_SCHED;
            PG8_LDA(At, 0, 1); PG8_STAGE(PG8_SB(0, 0), b2, voffB); PG8_STAGE(PG8_SB(0, 1), b2 + hstep, voffB); PG8_STAGE(PG8_SA(0, 0), a2, voffA);
            PG8_WAIT_V(8); PG8_WAIT_L(0); PG8_BAR; PG8_MMA(1, 0, At, B0); PG8_MMA(1, 1, At, B1); PG8_BAR; PG8_SCHED;
            PG8_LDB(B0, 1, 0); PG8_LDB(B1, 1, 1); PG8_SCHED; PG8_LDA(At, 1, 0); PG8_STAGE(PG8_SA(0, 1), a2 + hstep, voffA);
            PG8_WAIT_V(8); PG8_WAIT_L(0); PG8_BAR; PG8_MMA(0, 0, At, B0); PG8_MMA(0, 1, At, B1); PG8_BAR; PG8_SCHED;
            PG8_LDA(At, 1, 1); PG8_STAGE(PG8_SB(1, 0), b3, voffB); PG8_STAGE(PG8_SB(1, 1), b3 + hstep, voffB); PG8_STAGE(PG8_SA(1, 0), a3, voffA);
            PG8_WAIT_V(8); PG8_WAIT_L(0); PG8_BAR; PG8_MMA(1, 0, At, B0); PG8_MMA(1, 1, At, B1); PG8_BAR; PG8_SCHED;
            } else {
            PG8_LDB(B0, 0, 0); PG8_SCHED; PG8_LDA(At, 0, 0); PG8_STAGE(PG8_SA(1, 1), a1 + hstep, voffA);
            PG8_WAIT_L(8); PG8_BAR; PG8_WAIT_L(0); PG8_MMA(0, 0, At, B0); PG8_BAR; PG8_SCHED;
            PG8_LDB(B1, 0, 1); PG8_STAGE(PG8_SB(0, 0), b2, voffB);
            PG8_BAR; PG8_WAIT_L(0); PG8_MMA(0, 1, At, B1); PG8_BAR;
            PG8_LDA(At, 0, 1); PG8_STAGE(PG8_SA(0, 0), a2, voffA);
            PG8_BAR; PG8_WAIT_L(0); PG8_MMA(1, 0, At, B0); PG8_BAR; PG8_SCHED;
            PG8_STAGE(PG8_SB(0, 1), b2 + hstep, voffB);
            PG8_WAIT_V(6); PG8_BAR; PG8_MMA(1, 1, At, B1); PG8_BAR;
            PG8_LDB(B0, 1, 0); PG8_SCHED; PG8_LDA(At, 1, 0); PG8_STAGE(PG8_SA(0, 1), a2 + hstep, voffA);
            PG8_WAIT_L(8); PG8_BAR; PG8_WAIT_L(0); PG8_MMA(0, 0, At, B0); PG8_BAR; PG8_SCHED;
            PG8_LDB(B1, 1, 1); PG8_STAGE(PG8_SB(1, 0), b3, voffB);
            PG8_BAR; PG8_WAIT_L(0); PG8_MMA(0, 1, At, B1); PG8_BAR;
            PG8_LDA(At, 1, 1); PG8_STAGE(PG8_SA(1, 0), a3, voffA);
            PG8_BAR; PG8_WAIT_L(0); PG8_MMA(1, 0, At, B0); PG8_BAR; PG8_SCHED;
            PG8_STAGE(PG8_SB(1, 1), b3 + hstep, voffB);
            PG8_WAIT_V(6); PG8_BAR; PG8_MMA(1, 1, At, B1); PG8_BAR;
            }
        }
        if constexpr (ALIGN_EPI) { if (wr == 0) PG8_BAR; }
        if constexpr (!Epi::AFTER_DRAIN) { E(acc, cur, wr, wc, fr, fq); S.done(cur); }
        if (!has_next) break;
#pragma unroll
        for (int a = 0; a < 2; ++a)
#pragma unroll
            for (int b = 0; b < 2; ++b)
#pragma unroll
                for (int m = 0; m < 4; ++m)
#pragma unroll
                    for (int n = 0; n < 2; ++n) acc[a][b][m][n] = (f32x4){0.f, 0.f, 0.f, 0.f};
        cur = nxt; cA = nA; cB = nB; ++ui;
        if constexpr (ALIGN_EPI) { if (wr == 1) PG8_BAR; }
    }
    PG8_WAIT_V(0);
    if constexpr (!ALIGN_EPI) { if (wr == 0) PG8_BAR; }
    PG8_BAR;
    if constexpr (Epi::AFTER_DRAIN) { E.fused(acc, cur, wr, wc, fr, fq, lds, wid, lane); S.done(cur); }
#undef PG8_SA
#undef PG8_SB
#undef PG8_STAGE
#undef PG8_LDA
#undef PG8_LDB
#undef PG8_MMA
#undef PG8_WAIT_V
#undef PG8_WAIT_L
#undef PG8_BAR
#undef PG8_SCHED
}
}
#define GAS __attribute__((address_space(1)))
#define LAS __attribute__((address_space(3)))
typedef unsigned short bf16;
typedef unsigned v4u __attribute__((ext_vector_type(4)));
typedef float f32x4 __attribute__((ext_vector_type(4)));
typedef short bf16x8 __attribute__((ext_vector_type(8)));
typedef GAS unsigned gu32;
typedef GAS unsigned long long gu64;
#define RLX_AGENT __ATOMIC_RELAXED, __HIP_MEMORY_SCOPE_AGENT
#define LDS_WAIT() asm volatile("s_waitcnt lgkmcnt(0)" ::: "memory")
#define VM_WAIT() asm volatile("s_waitcnt vmcnt(0)" ::: "memory")
__device__ __forceinline__ unsigned long long rt() { return __builtin_amdgcn_s_memrealtime(); }
__device__ __forceinline__ unsigned f2bf(float f) { unsigned u = __builtin_bit_cast(unsigned, f); return (u + 0x7fffu + ((u >> 16) & 1u)) >> 16; }
__device__ __forceinline__ unsigned pk2(float lo, float hi) { return f2bf(lo) | (f2bf(hi) << 16); }

#define XB_TMO      128
#define XB_XCNT(j)  (256  + 64 * (j))
#define XB_XSUB(j)  (1280 + 64 * (j))
#define XB_XGEN(j)  (2304 + 64 * (j))
#define XB_TOP      3328
#define XB_TOPGEN   3392
#define XCD_BAR_WORDS 3456
#define XB_SPIN_CAP (1u << 18)

__device__ __forceinline__ unsigned xb_ld(unsigned* p)              { return __hip_atomic_load(p, __ATOMIC_RELAXED, __HIP_MEMORY_SCOPE_AGENT); }
__device__ __forceinline__ unsigned xb_add(unsigned* p, unsigned v) { return __hip_atomic_fetch_add(p, v, __ATOMIC_RELAXED, __HIP_MEMORY_SCOPE_AGENT); }
__device__ __forceinline__ unsigned xb_xcc_id() { return (unsigned)__builtin_amdgcn_s_getreg((3 << 11) | 20) & 0xFu; }
#define XB_SPIN(cond, bar) do { unsigned _sp = 0; while (cond) { __builtin_amdgcn_s_sleep(1); \
    if ((++_sp & 255u) == 0u) { if (xb_ld(&(bar)[XB_TMO])) break; if (_sp > XB_SPIN_CAP) { atomicAdd(&(bar)[XB_TMO], 1u); break; } } } } while (0)

struct XcdBarrier {
    unsigned* bar; unsigned x;
    volatile LAS unsigned* st;
};

__device__ __forceinline__ XcdBarrier xcd_barrier_post(unsigned* bar, volatile LAS unsigned* st) {
    XcdBarrier b; b.bar = bar; b.x = xb_xcc_id(); b.st = st;
    if (threadIdx.x == 0) (void)xb_add(&bar[XB_XCNT(b.x)], 1u);
    return b;
}
__device__ __forceinline__ void xcd_barrier_complete(unsigned* bar, unsigned x, unsigned& nloc, unsigned& nx) {
    const unsigned G = gridDim.x * gridDim.y * gridDim.z;
    unsigned sum, cnt, mine, sp = 0u;
    for (;;) {
        sum = 0u; cnt = 0u; mine = 0u;
#pragma unroll
        for (unsigned j = 0; j < 16; ++j) { const unsigned c = xb_ld(&bar[XB_XCNT(j)]); sum += c; cnt += (c > 0u) ? 1u : 0u; mine = (j == x) ? c : mine; }
        if (sum == G) break;
        __builtin_amdgcn_s_sleep(1);
        if ((++sp & 255u) == 0u) { if (xb_ld(&bar[XB_TMO])) break; if (sp > XB_SPIN_CAP) { atomicAdd(&bar[XB_TMO], 1u); break; } }
    }
    nloc = mine > 0u ? mine : 1u; nx = cnt > 0u ? cnt : 1u;
}

__device__ __forceinline__ void xcd_barrier(const XcdBarrier& b) {
    asm volatile("s_waitcnt vmcnt(0)" ::: "memory");
    __syncthreads();
    if (threadIdx.x == 0) {
        unsigned* bar = b.bar;
        __builtin_amdgcn_s_waitcnt(0);
        unsigned nloc = b.st[0], nx = b.st[1];
        if (nloc == 0u) { xcd_barrier_complete(bar, b.x, nloc, nx); b.st[0] = nloc; b.st[1] = nx; }
        const unsigned old = xb_add(&bar[XB_XSUB(b.x)], 1u);
        const unsigned gen = old / nloc;
        if (old + 1u == (gen + 1u) * nloc) {
            __builtin_amdgcn_fence(__ATOMIC_RELEASE, "agent");
            asm volatile("s_waitcnt vmcnt(0)" ::: "memory");
            const unsigned og = xb_add(&bar[XB_TOP], 1u);
            const unsigned tg = og / nx;
            if (og + 1u == (tg + 1u) * nx) xb_add(&bar[XB_TOPGEN], 1u);
            else XB_SPIN(xb_ld(&bar[XB_TOPGEN]) == tg, bar);
            __builtin_amdgcn_fence(__ATOMIC_ACQUIRE, "agent");
            xb_add(&bar[XB_XGEN(b.x)], 1u);
            asm volatile("s_waitcnt vmcnt(0)" ::: "memory");
        } else {
            XB_SPIN(xb_ld(&bar[XB_XGEN(b.x)]) == gen, bar);
            __builtin_amdgcn_fence(__ATOMIC_ACQUIRE, "agent");
            asm volatile("s_waitcnt vmcnt(0)" ::: "memory");
        }
    }
    __syncthreads();
}

constexpr int NWAVES = 8, NTHR = NWAVES * 64;
constexpr int D = 1024, NCTX_B = 16, SEQ = 256, DEPTH = 4, NLAT_B = 4, LSEQ = 2048, PAST = 512;
constexpr int NCTX = NCTX_B * SEQ, NLAT = NLAT_B * LSEQ, NTOK = NCTX + NLAT;
constexpr int GWID = 64, NH = 16, DH = 64, CK = 31, NMG = 5;
constexpr float EPS = 1e-6f;
constexpr float LOG2E_F = 1.4426950408889634f;

constexpr size_t MiB = 1u << 20;
constexpr size_t WS_CTL = 0, CTL_ZERO_BYTES = 64 * 1024;
constexpr int CW_BAR = 4096;
constexpr size_t WS_MOD = 1 * MiB;
constexpr size_t WS_GS = WS_MOD + 256 * 1024;
constexpr size_t WS_BIAS = WS_MOD + 512 * 1024;
constexpr size_t WS_SSP = 2 * MiB;
constexpr size_t WS_WCI = 4 * MiB;
constexpr size_t WS_WCO = WS_WCI + 2 * (size_t)3072 * 1024 * 2;
constexpr size_t WS_WNI = WS_WCO + 2 * (size_t)1024 * 1024 * 2;
constexpr size_t WS_WNO = WS_WNI + 2 * (size_t)4096 * 1024 * 2;
constexpr size_t WS_CKB = 44 * MiB;
constexpr size_t WS_CVB = WS_CKB + (size_t)NLAT_B * 2 * PAST * D * 2;
constexpr size_t ACT_BYTES = (size_t)NTOK * D * 2;
constexpr size_t WS_XS = 64 * MiB, WS_G = 88 * MiB, WS_B0 = 112 * MiB, WS_B1 = 136 * MiB, WS_B2 = 160 * MiB, WS_B3 = 184 * MiB, WS_END = 208 * MiB;
static_assert(WS_WNO + 2 * (size_t)1024 * 1024 * 2 <= WS_CKB && WS_CVB + (size_t)NLAT_B * 2 * PAST * D * 2 <= WS_XS && ACT_BYTES <= 24 * MiB, "d_ws map");

constexpr int RING_OFF = 0, RING_BYTES = 131072;
constexpr int LDSCTL_OFF = RING_BYTES, MISC_OFF = LDSCTL_OFF + 320;
constexpr int LDS_BYTES = 147456;

struct Args {
    const float* in[19]; float* out; unsigned char* ws; int ph_lo, ph_hi;
};

struct Frame {
    LAS unsigned char* lds; volatile LAS unsigned* MISC; gu32* ctl;
    int tid, lane, wave, vcu, G;
};

__device__ __forceinline__ int opaque(int x) { asm volatile("" : "+v"(x)); return x; }
__device__ __forceinline__ float wave_sum(float v) {
#pragma unroll
    for (int o = 1; o < 64; o <<= 1) v += __shfl_xor(v, o);
    return v;
}
__device__ __forceinline__ float bf2f(unsigned short b) { return __builtin_bit_cast(float, (unsigned)b << 16); }
__device__ __forceinline__ float bflo(unsigned w) { return __builtin_bit_cast(float, w << 16); }
__device__ __forceinline__ float bfhi(unsigned w) { return __builtin_bit_cast(float, w & 0xffff0000u); }
__device__ __forceinline__ float silu_f(float x) { return x * __builtin_amdgcn_rcpf(1.0f + __builtin_amdgcn_exp2f(-LOG2E_F * x)); }

__device__ __forceinline__ void transpose_item(const float* W, int K, int N, bf16* WT, int k0, int n0, int dst_row0, LAS float* scr, int lane) {
#pragma unroll 8
    for (int i = 0; i < 32; ++i) { const int kk = 2 * i + (lane >> 5); scr[kk * 33 + (lane & 31)] = W[(size_t)(k0 + kk) * N + n0 + (lane & 31)]; }
    LDS_WAIT(); asm volatile("" ::: "memory");
    const int c = lane & 7;
#pragma unroll
    for (int j = 0; j < 4; ++j) { const int n = (lane >> 3) + 8 * j; const LAS float* s = scr + (8 * c) * 33 + n;
        v4u o; o.x = pk2(s[0 * 33], s[1 * 33]); o.y = pk2(s[2 * 33], s[3 * 33]); o.z = pk2(s[4 * 33], s[5 * 33]); o.w = pk2(s[6 * 33], s[7 * 33]);
        *(GAS v4u*)(WT + (size_t)(dst_row0 + n) * K + k0 + 8 * c) = o; }
    LDS_WAIT(); asm volatile("" ::: "memory");
}
__device__ __forceinline__ int conv_in_row(int n) { return n < 1024 ? ((n >> 7) * 256 + (n & 127)) : (n < 2048 ? (((n - 1024) >> 7) * 256 + 128 + (n & 127)) : n); }

__device__ __forceinline__ void phase_p0a(Frame& F, const Args& a) {
    const float* c = a.in[2]; const float* cache_k = a.in[3]; const float* cache_v = a.in[4]; const float* c_ctx = a.in[5];
    const float* ada_w = a.in[7]; const float* ada_b = a.in[8];
    float* mod = (float*)(a.ws + WS_MOD);
    {
        LAS float* sc = (LAS float*)(F.lds);
        LAS float* red = (LAS float*)(F.lds + 20480);
        for (int i = F.tid; i < NMG * D; i += NTHR) { const int v = i >> 10, k = i & 1023; const float x = v == 0 ? c_ctx[k] : c[(v - 1) * D + k]; sc[i] = silu_f(x); }
        __syncthreads();
        for (int it = blockIdx.x; it < DEPTH * 48; it += F.G) {
            const int layer = it / 48, n0 = (it % 48) * 64;
            const float* w = ada_w + (size_t)layer * D * 3 * D + n0 + F.lane;
            float acc[NMG] = {0.f, 0.f, 0.f, 0.f, 0.f};
            const int kb = F.wave * 128;
#pragma unroll 8
            for (int k = 0; k < 128; ++k) { const float wv = w[(size_t)(kb + k) * 3 * D];
#pragma unroll
                for (int v = 0; v < NMG; ++v) acc[v] += sc[v * D + kb + k] * wv; }
#pragma unroll
            for (int v = 0; v < NMG; ++v) red[(F.wave * NMG + v) * 64 + F.lane] = acc[v];
            __syncthreads();
            if (F.tid < NMG * 64) { const int v = F.tid >> 6, l = F.tid & 63; float s = 0.f;
#pragma unroll
                for (int w8 = 0; w8 < 8; ++w8) s += red[(w8 * NMG + v) * 64 + l];
                mod[((size_t)v * DEPTH + layer) * 3 * D + n0 + l] = s + ada_b[layer * 3 * D + n0 + l]; }
            __syncthreads();
        }
        __syncthreads();
    }
    {
        LAS float* scr = (LAS float*)(F.lds + F.wave * 16384);
        const int gw = F.vcu * NWAVES + F.wave, NGW = F.G * NWAVES;
        constexpr int I_CI = 16 * 96, I_CO = 16 * 32, I_NI = 16 * 128, I_NO = 16 * 32;
        constexpr int NITEMS = 2 * (I_CI + I_CO + I_NI + I_NO);
        for (int it = gw; it < NITEMS; it += NGW) {
            int r = it;
            if (r < 2 * I_CI) { const int j = r / I_CI; r %= I_CI; const int kb = r / 96, nb = r % 96;
                transpose_item(a.in[9] + (size_t)j * D * 3072, D, 3072, (bf16*)(a.ws + WS_WCI) + (size_t)j * 3072 * D, kb * 64, nb * 32, conv_in_row(nb * 32), scr, F.lane); continue; }
            r -= 2 * I_CI;
            if (r < 2 * I_CO) { const int j = r / I_CO; r %= I_CO; const int kb = r / 32, nb = r % 32;
                transpose_item(a.in[14] + (size_t)j * D * D, D, D, (bf16*)(a.ws + WS_WCO) + (size_t)j * D * D, kb * 64, nb * 32, nb * 32, scr, F.lane); continue; }
            r -= 2 * I_CO;
            if (r < 2 * I_NI) { const int j = r / I_NI; r %= I_NI; const int kb = r / 128, nb = r % 128;
                transpose_item(a.in[15] + (size_t)j * D * 4096, D, 4096, (bf16*)(a.ws + WS_WNI) + (size_t)j * 4096 * D, kb * 64, nb * 32, nb * 32, scr, F.lane); continue; }
            r -= 2 * I_NI;
            { const int j = r / I_NO; r %= I_NO; const int kb = r / 32, nb = r % 32;
                transpose_item(a.in[17] + (size_t)j * D * D, D, D, (bf16*)(a.ws + WS_WNO) + (size_t)j * D * D, kb * 64, nb * 32, nb * 32, scr, F.lane); }
        }
        constexpr int CITEMS = NLAT_B * 2 * PAST * D / 512;
        for (int it = gw; it < 2 * CITEMS; it += NGW) {
            const bool isv = it >= CITEMS; const int r = isv ? it - CITEMS : it;
            const float* src = (isv ? cache_v : cache_k) + (size_t)r * 512 + F.lane * 8;
            bf16* dst = (bf16*)(a.ws + (isv ? WS_CVB : WS_CKB)) + (size_t)r * 512 + F.lane * 8;
            const f32x4 x0 = *(const f32x4*)src, x1 = *(const f32x4*)(src + 4);
            v4u o; o.x = pk2(x0[0], x0[1]); o.y = pk2(x0[2], x0[3]); o.z = pk2(x1[0], x1[1]); o.w = pk2(x1[2], x1[3]);
            *(v4u*)dst = o;
        }
    }
}

__device__ __forceinline__ void phase_p0b(Frame& F, const Args& a) {
    const float* mod = (const float*)(a.ws + WS_MOD); const float* norm_g = a.in[6];
    float* GS = (float*)(a.ws + WS_GS); float* BIAS = (float*)(a.ws + WS_BIAS); float* ssp = (float*)(a.ws + WS_SSP);
    bf16* XS = (bf16*)(a.ws + WS_XS);
    const int gw = F.vcu * NWAVES + F.wave, NGW = F.G * NWAVES;
    for (int i = (blockIdx.x * NTHR + F.tid); i < DEPTH * NMG * D; i += F.G * NTHR) { const int layer = i / (NMG * D), mg = (i / D) % NMG, k = i % D;
        GS[i] = norm_g[layer * D + k] * (1.0f + mod[((size_t)mg * DEPTH + layer) * 3 * D + D + k]); }
    for (int t = gw; t < NTOK; t += NGW) {
        const float* xr = t < NCTX ? a.in[0] + (size_t)t * D : a.in[1] + (size_t)(t - NCTX) * D;
        const int mg = t < NCTX ? 0 : 1 + (t - NCTX) / LSEQ;
        const float* sc = mod + ((size_t)mg * DEPTH + 0) * 3 * D + D; const float* ng = norm_g;
        float s = 0.f;
#pragma unroll
        for (int jj = 0; jj < 4; ++jj) { const int k = jj * 256 + F.lane * 4; const f32x4 v = *(const f32x4*)(xr + k); const f32x4 g4 = *(const f32x4*)(ng + k); const f32x4 s4 = *(const f32x4*)(sc + k);
            s += (v[0] * v[0] + v[1] * v[1]) + (v[2] * v[2] + v[3] * v[3]);
            const f32x4 o = v * g4 * (s4 + 1.0f);
            unsigned long long w = (unsigned long long)pk2(o[0], o[1]) | ((unsigned long long)pk2(o[2], o[3]) << 32);
            *(unsigned long long*)(XS + (size_t)t * D + k) = w; }
        s = wave_sum(s);
        if (F.lane < 16) ssp[(size_t)t * 16 + F.lane] = F.lane == 0 ? s : 0.f;
    }
    {
        LAS float* sh = (LAS float*)F.lds;
        int cur_layer = -1;
        for (int it = blockIdx.x; it < 224; it += F.G) {
            int layer, chunk; if (it < 48) { layer = 0; chunk = it; } else if (it < 112) { layer = 1; chunk = it - 48; } else if (it < 160) { layer = 2; chunk = it - 112; } else { layer = 3; chunk = it - 160; }
            if (layer != cur_layer) { __syncthreads();
                for (int i = F.tid; i < NMG * D; i += NTHR) sh[i] = mod[((size_t)(i >> 10) * DEPTH + layer) * 3 * D + (i & 1023)];
                cur_layer = layer; __syncthreads(); }
            const bf16* WT = (layer & 1) ? (const bf16*)(a.ws + WS_WNI) + (size_t)(layer >> 1) * 4096 * D : (const bf16*)(a.ws + WS_WCI) + (size_t)(layer >> 1) * 3072 * D;
            for (int rr = 0; rr < 8; ++rr) { const int n = chunk * 64 + F.wave * 8 + rr;
                const v4u w0 = *(const v4u*)(WT + (size_t)n * D + F.lane * 16), w1 = *(const v4u*)(WT + (size_t)n * D + F.lane * 16 + 8);
                float wf[16] = {bflo(w0.x), bfhi(w0.x), bflo(w0.y), bfhi(w0.y), bflo(w0.z), bfhi(w0.z), bflo(w0.w), bfhi(w0.w),
                                bflo(w1.x), bfhi(w1.x), bflo(w1.y), bfhi(w1.y), bflo(w1.z), bfhi(w1.z), bflo(w1.w), bfhi(w1.w)};
#pragma unroll
                for (int v = 0; v < NMG; ++v) { float s = 0.f;
#pragma unroll
                    for (int q = 0; q < 16; ++q) s += wf[q] * sh[v * D + F.lane * 16 + q];
                    s = wave_sum(s);
                    if (F.lane == 0) BIAS[((size_t)layer * NMG + v) * 4096 + n] = s; } }
        }
    }
}


constexpr int CONV_TT = 16, CONV_ROWS = CONV_TT + CK - 1;
__device__ __forceinline__ void phase_conv(Frame& F, const Args& a, int j) {
    const bf16* U = (const bf16*)(a.ws + WS_B0); const bf16* SZ = (const bf16*)(a.ws + WS_B1); bf16* Gb = (bf16*)(a.ws + WS_G);
    const float* dw_w = a.in[10] + (size_t)j * CK * D; const float* dw_b = a.in[11] + j * D; const float* ln_g = a.in[12] + j * D; const float* ln_b = a.in[13] + j * D;
    const int tid = opaque(F.tid), lane = tid & 63;
    typedef float f32x2 __attribute__((ext_vector_type(2)));
    f32x2 w[CK];
#pragma unroll
    for (int k = 0; k < CK; ++k) w[k] = *(const f32x2*)(dw_w + k * D + 2 * tid);
    const f32x2 cb = *(const f32x2*)(dw_b + 2 * tid), lg = *(const f32x2*)(ln_g + 2 * tid), lb = *(const f32x2*)(ln_b + 2 * tid);
    LAS unsigned char* rows = F.lds;
    LAS float* red = (LAS float*)(F.lds + CONV_ROWS * 2048);
    LAS float* stats = red + 256;
    for (int item = blockIdx.x; item < NTOK / CONV_TT; item += F.G) {
        const int t0 = item * CONV_TT;
        int s0, len; if (t0 < NCTX) { s0 = (t0 / SEQ) * SEQ; len = SEQ; } else { s0 = NCTX + ((t0 - NCTX) / LSEQ) * LSEQ; len = LSEQ; }
        for (int q = tid; q < CONV_ROWS * 128; q += NTHR) { const int row = q >> 7, ch = q & 127; const int tok = t0 - (CK / 2) + row;
            v4u v = {0u, 0u, 0u, 0u};
            if (tok >= s0 && tok < s0 + len) v = *(const v4u*)(U + (size_t)tok * D + ch * 8);
            *(LAS v4u*)(rows + row * 2048 + ch * 16) = v; }
        unsigned szw[CONV_TT];
#pragma unroll
        for (int l = 0; l < CONV_TT; ++l) szw[l] = *(const unsigned*)(SZ + (size_t)(t0 + l) * D + 2 * tid);
        __syncthreads();
        float o0[CONV_TT], o1[CONV_TT];
#pragma unroll
        for (int l = 0; l < CONV_TT; ++l) { o0[l] = cb.x; o1[l] = cb.y; }
#pragma unroll
        for (int r = 0; r < CONV_ROWS; ++r) { const unsigned uw = *(const LAS unsigned*)(rows + r * 2048 + tid * 4); const float u0 = bflo(uw), u1 = bfhi(uw);
#pragma unroll
            for (int l = 0; l < CONV_TT; ++l) { const int k = r - l; if (k >= 0 && k < CK) { o0[l] += u0 * w[k].x; o1[l] += u1 * w[k].y; } }
            if ((r & 3) == 3) asm volatile("" ::: "memory"); }
        float v[32];
#pragma unroll
        for (int l = 0; l < CONV_TT; ++l) { v[l] = o0[l] + o1[l]; v[16 + l] = o0[l] * o0[l] + o1[l] * o1[l]; }
#pragma unroll
        for (int s = 0; s < 5; ++s) { const int hn = 16 >> s; const unsigned upm = 0u - ((unsigned)(lane >> s) & 1u);
#pragma unroll
            for (int i = 0; i < hn; ++i) { const unsigned a_ = __float_as_uint(v[i]), b_ = __float_as_uint(v[i + hn]);
                const float keep = __uint_as_float((b_ & upm) | (a_ & ~upm)), send = __uint_as_float((a_ & upm) | (b_ & ~upm)); v[i] = keep + __shfl_xor(send, 1 << s); } }
        v[0] += __shfl_xor(v[0], 32);
        if (lane < 32) { const int idx = ((lane & 1) << 4) | ((lane & 2) << 2) | (lane & 4) | ((lane & 8) >> 2) | ((lane & 16) >> 4); red[F.wave * 32 + idx] = v[0]; }
        __syncthreads();
        if (tid < 32) { float s = 0.f;
#pragma unroll
            for (int w8 = 0; w8 < 8; ++w8) s += red[w8 * 32 + tid];
            stats[tid] = s; }
        __syncthreads();
#pragma unroll
        for (int l = 0; l < CONV_TT; ++l) { const float mu = stats[l] * (1.0f / D); const float var = stats[16 + l] * (1.0f / D) - mu * mu; const float rstd = __builtin_amdgcn_rsqf(var + EPS);
            const float y0 = (o0[l] - mu) * rstd * lg.x + lb.x, y1 = (o1[l] - mu) * rstd * lg.y + lb.y;
            *(unsigned*)(Gb + (size_t)(t0 + l) * D + 2 * tid) = pk2(silu_f(y0) * bflo(szw[l]), silu_f(y1) * bfhi(szw[l])); }
    }
    __syncthreads();
}

namespace att {
typedef float f32x16 __attribute__((ext_vector_type(16)));
typedef short s16x4 __attribute__((ext_vector_type(4)));
constexpr int SLOT = 16384, KOFF = 0, VOFF = 8192, NSLOT = 4;
constexpr int TBL_OFF = NSLOT * SLOT, TBL_STRIDE = 80  , WSF_OFF = TBL_OFF + 6144, STG_ROW = 272  ;
constexpr float THR = 8.0f, NEG = -1.0e30f;
#ifndef ATT_PINGPONG
#define ATT_PINGPONG 0
#endif
__device__ __forceinline__ int crow(int r, int hi) { return (r & 3) + 8 * (r >> 2) + 4 * hi; }
__device__ __forceinline__ unsigned cvtpk(float lo, float hi) { unsigned r; asm volatile("v_cvt_pk_bf16_f32 %0, %1, %2" : "=v"(r) : "v"(lo), "v"(hi)); return r; }
__device__ __forceinline__ s16x4 vtr(const LAS unsigned char* p) { return __builtin_bit_cast(s16x4, __builtin_amdgcn_ds_read_tr16_b64_v4i16((LAS s16x4*)p)); }
__device__ __forceinline__ float swapmax(float m) { auto rr = __builtin_amdgcn_permlane32_swap(__float_as_uint(m), __float_as_uint(m), false, false); return fmaxf(__uint_as_float(rr[0]), __uint_as_float(rr[1])); }
__device__ __forceinline__ float swapadd(float m) { auto rr = __builtin_amdgcn_permlane32_swap(__float_as_uint(m), __float_as_uint(m), false, false); return __uint_as_float(rr[0]) + __uint_as_float(rr[1]); }
struct Params { const bf16 *Q, *K, *V, *SZ, *CK, *CV; bf16* G; const float* rpb; int j; };
__device__ __forceinline__ bf16x8 packp(const f32x16& p, int s8) {
    v4u w; w.x = cvtpk(p[s8 + 0], p[s8 + 1]); w.y = cvtpk(p[s8 + 2], p[s8 + 3]); w.z = cvtpk(p[s8 + 4], p[s8 + 5]); w.w = cvtpk(p[s8 + 6], p[s8 + 7]);
    return __builtin_bit_cast(bf16x8, w);
}
__device__ __forceinline__ float max16(const f32x16& p) {
    const float a = fmaxf(fmaxf(p[0], p[1]), p[2]), b = fmaxf(fmaxf(p[3], p[4]), p[5]), c = fmaxf(fmaxf(p[6], p[7]), p[8]), d = fmaxf(fmaxf(p[9], p[10]), p[11]);
    const float e = fmaxf(fmaxf(p[12], p[13]), p[14]);
    return fmaxf(fmaxf(fmaxf(a, b), c), fmaxf(fmaxf(d, e), p[15]));
}
__device__ __forceinline__ void glds16(const void* gsrc, unsigned lds_dst) { unsigned keep;
    asm volatile("s_mov_b32 %0, m0\n\ts_mov_b32 m0, %2\n\ts_nop 0\n\tglobal_load_lds_dwordx4 %1, off\n\ts_mov_b32 m0, %0" : "=&s"(keep) : "v"(gsrc), "s"(lds_dst) : "memory"); }
#define ATT_WAIT_BAR(N) asm volatile("s_waitcnt vmcnt(" #N ") lgkmcnt(0)\n\ts_barrier" ::: "memory")

template <bool FULL> __device__ __forceinline__ void qk_tile(f32x16 (&p)[2], const LAS unsigned char* kb, const bf16x8 (&qr)[4], const f32x16& cinit) {
#pragma unroll
    for (int d0 = 0; d0 < 4; ++d0) { const bf16x8 k0 = *(const LAS bf16x8*)(kb + d0 * 2048);
        p[0] = __builtin_amdgcn_mfma_f32_32x32x16_bf16(k0, qr[d0], d0 == 0 ? cinit : p[0], 0, 0, 0);
        if (FULL) { const bf16x8 k1 = *(const LAS bf16x8*)(kb + d0 * 2048 + 512); p[1] = __builtin_amdgcn_mfma_f32_32x32x16_bf16(k1, qr[d0], d0 == 0 ? cinit : p[1], 0, 0, 0); } }
}
template <bool FULL> __device__ __forceinline__ void pv_tile(f32x16 (&o)[2], const f32x16 (&p)[2], const LAS unsigned char* vb) {
    const bf16x8 pa0 = packp(p[0], 0), pa1 = packp(p[0], 8);
    bf16x8 pa2 = pa0, pa3 = pa1; if (FULL) { pa2 = packp(p[1], 0); pa3 = packp(p[1], 8); }
#pragma unroll
    for (int d0 = 0; d0 < 2; ++d0) {
#pragma unroll
        for (int ks = 0; ks < (FULL ? 4 : 2); ++ks) { const s16x4 lo = vtr(vb + d0 * 4096 + ks * 1024), h4 = vtr(vb + d0 * 4096 + ks * 1024 + 512);
            const bf16x8 vf = (bf16x8){lo[0], lo[1], lo[2], lo[3], h4[0], h4[1], h4[2], h4[3]};
            o[d0] = __builtin_amdgcn_mfma_f32_32x32x16_bf16(ks == 0 ? pa0 : (ks == 1 ? pa1 : (ks == 2 ? pa2 : pa3)), vf, o[d0], 0, 0, 0); } }
}
struct Lane { float mh, l; int r32, hi; LAS float* wsf; bool na; int kc0, qs; };
template <int NP, bool FIRST, int NPEND> __device__ __forceinline__ void softmax_tile(f32x16 (&p)[2], f32x16 (&pend)[2], Lane& L, f32x16& negm, f32x16& cloc, f32x16 (&o)[2]) {
    float rm = max16(p[0]); if (NP == 2) rm = fmaxf(rm, max16(p[1]));
    rm = swapmax(rm);
    if (FIRST || __any(rm > THR)) {
        const float dl = FIRST ? rm : fmaxf(rm, 0.f);
        L.mh += dl;
#pragma unroll
        for (int r = 0; r < 16; ++r) { p[0][r] -= dl; if (NP == 2) p[1][r] -= dl; if (NPEND >= 1) pend[0][r] -= dl; if (NPEND == 2) pend[1][r] -= dl; }
        const float nm = -L.mh;
#pragma unroll
        for (int r = 0; r < 16; ++r) negm[r] = nm;
        if (L.na) {
#pragma unroll
            for (int r = 0; r < 16; ++r) { const int kc = L.kc0 + (r & 3) + 8 * (r >> 2); cloc[r] = (kc >= L.qs && kc < L.qs + 16) ? nm : NEG; } }
        if (!FIRST) { const float f = __builtin_amdgcn_exp2f(-dl); L.l *= f; if (L.hi == 0) L.wsf[L.r32] = f;
#pragma unroll
            for (int r = 0; r < 16; ++r) { const float al = L.wsf[crow(r, L.hi)]; o[0][r] *= al; o[1][r] *= al; } }
    }
    float s = 0.f;
#pragma unroll
    for (int r = 0; r < 16; ++r) { p[0][r] = __builtin_amdgcn_exp2f(p[0][r]); s += p[0][r]; }
    if (NP == 2) {
#pragma unroll
        for (int r = 0; r < 16; ++r) { p[1][r] = __builtin_amdgcn_exp2f(p[1][r]); s += p[1][r]; } }
    L.l += s;
}

__device__ __forceinline__ void attn_unit(Frame& F, const Params& P, int u) {
    const int tid = opaque(F.tid), lane = tid & 63, wid = F.wave, r32 = lane & 31, hi = lane >> 5;
    LAS unsigned char* lds = F.lds;
    const unsigned lds0 = (unsigned)(uintptr_t)lds;
    LAS float* tbl = (LAS float*)(lds + TBL_OFF);
    const bool is_na = u < 512;
    int b, h, ntiles, nfull, rlo = 0, r0 = 0;
    if (is_na) { b = u >> 7; h = (u >> 3) & 15; r0 = 4 * (u & 7); rlo = r0 - 4; rlo = rlo < 0 ? 0 : rlo; int rh = r0 - 1; rh = rh < 0 ? 0 : (rh > 24 ? 24 : rh); ntiles = 8 + (rh + 7 - rlo + 1); nfull = 8; }
    else { const int uu = u - 512; b = uu >> 4; h = uu & 15; ntiles = 4; nfull = 4; }
    int tq, rq = 0, cq = 0, bs = 0, ra = 0;
    if (is_na) { const int jb = wid >> 1; ra = r0 + 2 * (wid & 1); rq = ra + (r32 >> 4); cq = 16 * jb + (r32 & 15); tq = NCTX + b * LSEQ + rq * GWID + cq; bs = jb == 0 ? 0 : (jb == 1 ? 8 : (jb == 2 ? 24 : 32)); }
    else tq = b * SEQ + wid * 32 + r32;
    int rsq = rq - 4; rsq = rsq < 0 ? 0 : (rsq > 24 ? 24 : rsq);
    int qs = cq - 8; qs = qs < 0 ? 0 : (qs > 48 ? 48 : qs);
    int alo = ra - 4; alo = alo < 0 ? 0 : (alo > 24 ? 24 : alo); int ahi = ra - 3; ahi = ahi < 0 ? 0 : (ahi > 24 ? 24 : ahi); ahi += 8;
    const size_t koff = (size_t)lane * D + h * DH + wid * 8;
    const size_t voff = (size_t)(16 * (wid & 3) + (lane >> 2)) * D + h * DH + (wid >> 2) * 32 + (lane & 3) * 8;
    const unsigned kdst = lds0 + KOFF + wid * 1024, vdst = lds0 + VOFF + wid * 1024;
#define ATT_DMA(t) do { const bf16 *kp_, *vp_; \
        if (is_na && (t) < 8) { const size_t o_ = ((size_t)(b * 2 + P.j) * PAST + 64 * (t)) * D; kp_ = P.CK + o_; vp_ = P.CV + o_; } \
        else { const size_t o_ = (is_na ? (size_t)(NCTX + b * LSEQ + (rlo + (t) - 8) * GWID) : (size_t)(b * SEQ + 64 * (t))) * D; kp_ = P.K + o_; vp_ = P.V + o_; } \
        const unsigned so_ = (unsigned)((t) & (NSLOT - 1)) * SLOT; \
        glds16(kp_ + koff, (unsigned)__builtin_amdgcn_readfirstlane(kdst + so_)); glds16(vp_ + voff, (unsigned)__builtin_amdgcn_readfirstlane(vdst + so_)); } while (0)
    if (is_na) { for (int i = tid; i < 16 * TBL_STRIDE; i += NTHR) { const int row = i / TBL_STRIDE, x = i % TBL_STRIDE; float v = 0.f;
            if (row == 15) v = NEG; else if (x >= 16 && x < 47) v = P.rpb[((size_t)P.j * NH + h) * 465 + row * 31 + (x - 16)] * LOG2E_F;
            tbl[i] = v; } }
    bf16x8 qr[4];
#pragma unroll
    for (int d0 = 0; d0 < 4; ++d0) qr[d0] = *(const bf16x8*)(P.Q + (size_t)tq * D + h * DH + d0 * 16 + hi * 8);
    ATT_DMA(0); ATT_DMA(1); ATT_DMA(2);
    Lane L; L.mh = 0.f; L.l = 0.f; L.r32 = r32; L.hi = hi; L.wsf = (LAS float*)(lds + WSF_OFF) + wid * 32; L.na = is_na; L.kc0 = bs + 4 * hi; L.qs = qs;
    f32x16 o[2], negm, cloc;
#pragma unroll
    for (int r = 0; r < 16; ++r) { o[0][r] = 0.f; o[1][r] = 0.f; negm[r] = 0.f; cloc[r] = 0.f; }
    const unsigned vrd = VOFF + ((lane >> 4) & 1) * 32 + (lane & 3) * 8 + (4 * hi + ((lane & 15) >> 2)) * 64;
    const unsigned kfull = hi * 1024 + r32 * 16, kloc = hi * 1024 + (bs + r32) * 16, vloc = vrd + (bs >> 3) * 512;
    const int tb0 = 16 + bs - cq + 15 + 4 * hi;
    const bool late = ATT_PINGPONG && wid >= 4;
    f32x16 sa[2], sb[2];
#define ATT_SLOT(t) (lds + ((t) & (NSLOT - 1)) * SLOT)
#define ATT_SEAM(t) do { if ((t) + 3 <= ntiles) ATT_WAIT_BAR(2); else ATT_WAIT_BAR(0); if ((t) + 3 < ntiles) ATT_DMA((t) + 3); } while (0)
#define ATT_ALIVE(t) ((rlo + (t) - 8) >= alo && (rlo + (t) - 8) < ahi)
#define ATT_BIAS(S, t) do { const int rr_ = rlo + (t) - 8; const int rsel_ = (rr_ >= rsq && rr_ < rsq + 8) ? rr_ - rq + 7 : 15; const LAS float* tp_ = tbl + rsel_ * TBL_STRIDE + tb0; \
        _Pragma("unroll") for (int r = 0; r < 16; ++r) S[0][r] += tp_[(r & 3) + 8 * (r >> 2)]; } while (0)
#define ATT_P1 __builtin_amdgcn_s_setprio(1)
#define ATT_P0 __builtin_amdgcn_s_setprio(0)
#define ITER_FF(CUR, NXT, t, FIRST) do { ATT_SEAM(t); \
        if (!late) { ATT_P1; qk_tile<true>(NXT, ATT_SLOT((t) + 1) + kfull, qr, negm); ATT_P0; softmax_tile<2, FIRST, 2>(CUR, NXT, L, negm, cloc, o); ATT_P1; pv_tile<true>(o, CUR, ATT_SLOT(t) + vrd); ATT_P0; } \
        else { softmax_tile<2, FIRST, 0>(CUR, NXT, L, negm, cloc, o); ATT_P1; pv_tile<true>(o, CUR, ATT_SLOT(t) + vrd); qk_tile<true>(NXT, ATT_SLOT((t) + 1) + kfull, qr, negm); ATT_P0; } } while (0)
#define ITER_FL(CUR, NXT, t) do { ATT_SEAM(t); const bool an_ = ATT_ALIVE((t) + 1); \
        if (!late) { if (an_) { ATT_P1; qk_tile<false>(NXT, ATT_SLOT((t) + 1) + kloc, qr, cloc); ATT_P0; } softmax_tile<2, false, 1>(CUR, NXT, L, negm, cloc, o); ATT_P1; pv_tile<true>(o, CUR, ATT_SLOT(t) + vrd); ATT_P0; } \
        else { softmax_tile<2, false, 0>(CUR, NXT, L, negm, cloc, o); ATT_P1; pv_tile<true>(o, CUR, ATT_SLOT(t) + vrd); if (an_) qk_tile<false>(NXT, ATT_SLOT((t) + 1) + kloc, qr, cloc); ATT_P0; } } while (0)
#define ITER_LL(CUR, NXT, t) do { ATT_SEAM(t); const bool ac_ = ATT_ALIVE(t), an_ = ATT_ALIVE((t) + 1); \
        if (!late) { if (an_) { ATT_P1; qk_tile<false>(NXT, ATT_SLOT((t) + 1) + kloc, qr, cloc); ATT_P0; } \
            if (ac_) { ATT_BIAS(CUR, t); softmax_tile<1, false, 1>(CUR, NXT, L, negm, cloc, o); ATT_P1; pv_tile<false>(o, CUR, ATT_SLOT(t) + vloc); ATT_P0; } } \
        else { if (ac_) { ATT_BIAS(CUR, t); softmax_tile<1, false, 0>(CUR, NXT, L, negm, cloc, o); ATT_P1; pv_tile<false>(o, CUR, ATT_SLOT(t) + vloc); ATT_P0; } \
            if (an_) { ATT_P1; qk_tile<false>(NXT, ATT_SLOT((t) + 1) + kloc, qr, cloc); ATT_P0; } } } while (0)
#define LAST_L(CUR, t) do { if (ATT_ALIVE(t)) { ATT_BIAS(CUR, t); softmax_tile<1, false, 0>(CUR, CUR, L, negm, cloc, o); pv_tile<false>(o, CUR, ATT_SLOT(t) + vloc); } } while (0)
    ATT_WAIT_BAR(4);
    qk_tile<true>(sa, lds + kfull, qr, negm);
    int t = 0;
    ITER_FF(sa, sb, 0, true); t = 1;
    for (; t + 2 < nfull; t += 2) { ITER_FF(sb, sa, t, false); ITER_FF(sa, sb, t + 1, false); }
    if (is_na) {
        ITER_FL(sb, sa, t); ++t;
        for (; t + 2 < ntiles; t += 2) { ITER_LL(sa, sb, t); ITER_LL(sb, sa, t + 1); }
        if (t + 1 < ntiles) { ITER_LL(sa, sb, t); ++t; LAST_L(sb, t); } else LAST_L(sa, t);
    } else { softmax_tile<2, false, 0>(sb, sb, L, negm, cloc, o); pv_tile<true>(o, sb, ATT_SLOT(t) + vrd); }
#undef ATT_DMA
#undef ATT_SLOT
#undef ATT_SEAM
#undef ATT_ALIVE
#undef ATT_BIAS
#undef ATT_P1
#undef ATT_P0
#undef ITER_FF
#undef ITER_FL
#undef ITER_LL
#undef LAST_L
    float lt = swapadd(L.l);
    if (hi == 0) L.wsf[r32] = __builtin_amdgcn_rcpf(lt);
    ATT_WAIT_BAR(0);
    LAS unsigned char* stg = lds + wid * (32 * STG_ROW);
#pragma unroll
    for (int r = 0; r < 16; ++r) { const int qi = crow(r, hi); const float rl = L.wsf[qi];
        *(LAS float*)(stg + qi * STG_ROW + r32 * 4) = o[0][r] * rl; *(LAS float*)(stg + qi * STG_ROW + 128 + r32 * 4) = o[1][r] * rl; }
#pragma unroll
    for (int i = 0; i < 4; ++i) { const int qi = i * 8 + (lane >> 3), ch = lane & 7;
        int tok; if (is_na) tok = NCTX + b * LSEQ + (ra + (qi >> 4)) * GWID + 16 * (wid >> 1) + (qi & 15); else tok = b * SEQ + wid * 32 + qi;
        const f32x4 x0 = *(const LAS f32x4*)(stg + qi * STG_ROW + ch * 32), x1 = *(const LAS f32x4*)(stg + qi * STG_ROW + ch * 32 + 16);
        const size_t idx = (size_t)tok * D + h * DH + ch * 8;
        const v4u z = *(const v4u*)(P.SZ + idx);
        v4u w; w.x = cvtpk(x0[0] * bflo(z.x), x0[1] * bfhi(z.x)); w.y = cvtpk(x0[2] * bflo(z.y), x0[3] * bfhi(z.y)); w.z = cvtpk(x1[0] * bflo(z.z), x1[1] * bfhi(z.z)); w.w = cvtpk(x1[2] * bflo(z.w), x1[3] * bfhi(z.w));
        *(v4u*)(P.G + idx) = w; }
    ATT_WAIT_BAR(0);
}
}
__device__ __forceinline__ void phase_attn(Frame& F, const Args& a, int j) {
    att::Params P{(const bf16*)(a.ws + WS_B0), (const bf16*)(a.ws + WS_B2), (const bf16*)(a.ws + WS_B3), (const bf16*)(a.ws + WS_B1), (const bf16*)(a.ws + WS_CKB), (const bf16*)(a.ws + WS_CVB),
                  (bf16*)(a.ws + WS_G), a.in[16], j};
    for (int u = F.vcu; u < 768; u += F.G) att::attn_unit(F, P, u);
}

__device__ __forceinline__ void phase_final(Frame& F, const Args& a) {
    const float* ssp = (const float*)(a.ws + WS_SSP); const float* fg = a.in[18];
    const int gw = F.vcu * NWAVES + F.wave, NGW = F.G * NWAVES;
    for (int t = gw; t < NTOK; t += NGW) {
        const float rs = pg8::row_rscale(ssp, t);
        float* xr = a.out + (size_t)t * D;
#pragma unroll
        for (int jj = 0; jj < 4; ++jj) { const int k = jj * 256 + F.lane * 4; f32x4 v = *(const f32x4*)(xr + k); const f32x4 g4 = *(const f32x4*)(fg + k);
            *(f32x4*)(xr + k) = v * rs * g4; }
    }
}

#ifndef MK_ONE_LAUNCH
#define MK_ONE_LAUNCH 1
#endif
#ifndef REP_PHASE
#define REP_PHASE (-1)
#define REP_COUNT 1
#endif
#define NREP(k) ((k) == REP_PHASE ? REP_COUNT : 1)
constexpr int N_PHASES = 15;
__global__ void __launch_bounds__(NTHR, 2) mk_fwd(Args args) {
    extern __shared__ __attribute__((aligned(16))) unsigned char lds[];
    Frame F;
    F.lds = (LAS unsigned char*)lds;
    F.MISC = (volatile LAS unsigned*)(F.lds + MISC_OFF);
    F.tid = threadIdx.x; asm volatile("" : "+v"(F.tid)); F.lane = F.tid & 63; F.wave = __builtin_amdgcn_readfirstlane(F.tid >> 6);
    F.G = gridDim.x; { const int bx = blockIdx.x; F.vcu = (F.G % 8 == 0) ? (bx % 8) * (F.G / 8) + bx / 8 : bx; }
    unsigned char* ws = args.ws;
    F.ctl = (gu32*)(ws + WS_CTL);
    const int lo = args.ph_lo, hi = args.ph_hi;
#define IN(k) (lo <= (k) && (k) < hi)
    for (int u = F.tid; u < (LDS_BYTES - LDSCTL_OFF) / 4; u += NTHR) ((LAS unsigned*)(F.lds + LDSCTL_OFF))[u] = 0u;
    __syncthreads();
    XcdBarrier bar = xcd_barrier_post((unsigned*)(F.ctl + CW_BAR), F.MISC + 8);
#define BOTH(k) (IN(k) && IN((k) + 1))
#define SEAM(k) do { if (BOTH(k)) xcd_barrier(bar); } while (0)
    if (IN(0)) { for (int rep = 0; rep < NREP(0); ++rep) { phase_p0a(F, args); SEAM(0); } }
    if (IN(1)) { for (int rep = 0; rep < NREP(1); ++rep) { phase_p0b(F, args); SEAM(1); } }
    bf16* XS = (bf16*)(ws + WS_XS); bf16* G = (bf16*)(ws + WS_G); bf16* B0 = (bf16*)(ws + WS_B0); bf16* B1 = (bf16*)(ws + WS_B1); bf16* B2 = (bf16*)(ws + WS_B2); bf16* B3 = (bf16*)(ws + WS_B3);
    float* ssp = (float*)(ws + WS_SSP); const float* mod = (const float*)(ws + WS_MOD);
    float* x = args.out; float* newk = args.out + (size_t)NTOK * D; float* newv = newk + (size_t)NCTX_B * 2 * SEQ * D;
#pragma unroll 1
    for (int layer = 0; layer < DEPTH; ++layer) {
        const int j = layer >> 1;
        const float* bias = (const float*)(ws + WS_BIAS) + (size_t)layer * NMG * 4096;
        if (IN(2 + 3 * layer)) {
          for (int rep = 0; rep < NREP(2 + 3 * layer); ++rep) {
            if ((layer & 1) == 0) {
                pg8::Gemm g{XS, (const bf16*)(ws + WS_WCI) + (size_t)j * 3072 * D, NTOK, 3072, D}; pg8::StaticOrder S; S.init(NTOK, 3072, F.G, (int)blockIdx.x);
                pg8::EpiConv1 E{ssp, bias, B0, B1};
                pg8::gemm_phase<pg8::EpiConv1, pg8::StaticOrder, true, true>(F.lds + RING_OFF, g, S, E);
            } else {
                pg8::Gemm g{XS, (const bf16*)(ws + WS_WNI) + (size_t)j * 4096 * D, NTOK, 4096, D}; pg8::StaticOrder S; S.init(NTOK, 4096, F.G, (int)blockIdx.x);
                pg8::EpiAttn1 E{ssp, bias, B0, (size_t)(WS_B1 - WS_B0) / 2, newk, (size_t)NCTX_B * 2 * SEQ * D, j};
                pg8::gemm_phase<pg8::EpiAttn1, pg8::StaticOrder, true, true>(F.lds + RING_OFF, g, S, E);
            }
            SEAM(2 + 3 * layer);
          }
        }
        if (IN(3 + 3 * layer)) {
          for (int rep = 0; rep < NREP(3 + 3 * layer); ++rep) {
#ifndef NO_CONV
            if ((layer & 1) == 0) phase_conv(F, args, j);
#endif
#ifndef NO_ATTN
            if ((layer & 1) == 1) phase_attn(F, args, j);
#endif
            SEAM(3 + 3 * layer);
          }
        }
        if (IN(4 + 3 * layer)) {
          for (int rep = 0; rep < NREP(4 + 3 * layer); ++rep) {
            const bf16* WT = (layer & 1) ? (const bf16*)(ws + WS_WNO) + (size_t)j * D * D : (const bf16*)(ws + WS_WCO) + (size_t)j * D * D;
            pg8::Gemm g{G, WT, NTOK, D, D}; pg8::StaticOrder S; S.init(NTOK, D, F.G, (int)blockIdx.x);
            const float* bc = layer == 0 ? args.in[0] : x; const float* bl = layer == 0 ? args.in[1] : x + (size_t)NCTX * D;
            const float* gate = mod + (size_t)layer * 3 * D + 2 * D;
            if (layer < DEPTH - 1) {
                pg8::EpiGemm2<true> E{bc, bl, x, gate, DEPTH * 3 * D, (const float*)(ws + WS_GS) + (size_t)(layer + 1) * NMG * D, XS, ssp};
                pg8::gemm_phase<pg8::EpiGemm2<true>, pg8::StaticOrder, true, true>(F.lds + RING_OFF, g, S, E);
            } else {
                pg8::EpiGemm2<false> E{bc, bl, x, gate, DEPTH * 3 * D, nullptr, XS, ssp};
                pg8::gemm_phase<pg8::EpiGemm2<false>, pg8::StaticOrder, true, true>(F.lds + RING_OFF, g, S, E);
            }
            SEAM(4 + 3 * layer);
          }
        }
    }
    if (IN(14)) phase_final(F, args);
#undef IN
#undef BOTH
#undef SEAM
}

__global__ void __launch_bounds__(256) k_conv_b(const bf16* __restrict__ U, const bf16* __restrict__ SZ, const float* __restrict__ dw_w, const float* __restrict__ dw_b,
                                                 const float* __restrict__ ln_g, const float* __restrict__ ln_b, bf16* __restrict__ Gb) {
    const int t = blockIdx.x;
    int s0, len;
    if (t < NCTX) { s0 = (t / SEQ) * SEQ; len = SEQ; } else { s0 = NCTX + ((t - NCTX) / LSEQ) * LSEQ; len = LSEQ; }
    const int l = t - s0;
    float v[4]; float s = 0.f;
#pragma unroll
    for (int i = 0; i < 4; ++i) {
        int c = threadIdx.x + i * 256;
        float acc = dw_b[c];
        for (int k = 0; k < CK; ++k) { int ll = l + k - CK / 2; if (ll >= 0 && ll < len) acc += bf2f(U[(size_t)(s0 + ll) * D + c]) * dw_w[k * D + c]; }
        v[i] = acc; s += acc;
    }
    __shared__ float red[256];
    red[threadIdx.x] = s; __syncthreads();
    for (int o = 128; o > 0; o >>= 1) { if (threadIdx.x < o) red[threadIdx.x] += red[threadIdx.x + o]; __syncthreads(); }
    const float mu = red[0] / D; __syncthreads();
    float q = 0.f;
#pragma unroll
    for (int i = 0; i < 4; ++i) { float d = v[i] - mu; q += d * d; }
    red[threadIdx.x] = q; __syncthreads();
    for (int o = 128; o > 0; o >>= 1) { if (threadIdx.x < o) red[threadIdx.x] += red[threadIdx.x + o]; __syncthreads(); }
    const float rstd = rsqrtf(red[0] / D + EPS);
#pragma unroll
    for (int i = 0; i < 4; ++i) { int c = threadIdx.x + i * 256; float u = (v[i] - mu) * rstd * ln_g[c] + ln_b[c];
        Gb[(size_t)t * D + c] = (bf16)f2bf(silu_f(u) * bf2f(SZ[(size_t)t * D + c])); }
}

__global__ void __launch_bounds__(256) k_ctx_attn_b(const bf16* __restrict__ Q, const bf16* __restrict__ K, const bf16* __restrict__ V, const bf16* __restrict__ SZ, bf16* __restrict__ Gb) {
    const int t = blockIdx.x, h = blockIdx.y, b = t / SEQ;
    __shared__ float sq[DH]; __shared__ float sp[SEQ]; __shared__ float red[256];
    if (threadIdx.x < DH) sq[threadIdx.x] = bf2f(Q[(size_t)t * D + h * DH + threadIdx.x]);
    __syncthreads();
    const int l = threadIdx.x;
    const bf16* kr = K + (size_t)(b * SEQ + l) * D + h * DH;
    float sc = 0.f;
    for (int d = 0; d < DH; ++d) sc += sq[d] * bf2f(kr[d]);
    red[threadIdx.x] = sc; __syncthreads();
    for (int o = 128; o > 0; o >>= 1) { if (threadIdx.x < o) red[threadIdx.x] = fmaxf(red[threadIdx.x], red[threadIdx.x + o]); __syncthreads(); }
    const float mx = red[0]; __syncthreads();
    const float p = exp2f(sc - mx);
    sp[l] = p; red[threadIdx.x] = p; __syncthreads();
    for (int o = 128; o > 0; o >>= 1) { if (threadIdx.x < o) red[threadIdx.x] += red[threadIdx.x + o]; __syncthreads(); }
    const float inv = 1.f / red[0];
    if (threadIdx.x < DH) { const int d = threadIdx.x; float o = 0.f;
        for (int ll = 0; ll < SEQ; ++ll) o += sp[ll] * bf2f(V[(size_t)(b * SEQ + ll) * D + h * DH + d]);
        const size_t idx = (size_t)t * D + h * DH + d;
        Gb[idx] = (bf16)f2bf(o * inv * bf2f(SZ[idx])); }
}

__global__ void __launch_bounds__(256) k_na_attn_b(const bf16* __restrict__ Q, const bf16* __restrict__ K, const bf16* __restrict__ V, const bf16* __restrict__ SZ,
                                                    const bf16* __restrict__ CKb, const bf16* __restrict__ CVb, const float* __restrict__ rpb, int j, bf16* __restrict__ Gb) {
    const int tl = blockIdx.x, h = blockIdx.y;
    const int b = tl / LSEQ, n = tl % LSEQ, r = n / GWID, c = n % GWID;
    const int t = NCTX + tl;
    __shared__ float sq[DH]; __shared__ float sp[128 + PAST]; __shared__ float red[256];
    if (threadIdx.x < DH) sq[threadIdx.x] = bf2f(Q[(size_t)t * D + h * DH + threadIdx.x]);
    __syncthreads();
    int rs = r - 4; rs = rs < 0 ? 0 : (rs > 24 ? 24 : rs);
    int qs = c - 8; qs = qs < 0 ? 0 : (qs > 48 ? 48 : qs);
    const bf16* ck = CKb + ((size_t)(b * 2 + j) * PAST) * D + h * DH;
    const bf16* cv = CVb + ((size_t)(b * 2 + j) * PAST) * D + h * DH;
    const float* rp = rpb + ((size_t)j * NH + h) * 15 * 31;
    float mx = -3.0e38f;
    for (int i = threadIdx.x; i < 128 + PAST; i += 256) {
        float sc = 0.f;
        if (i < 128) { int rr = rs + i / 16, kc = qs + i % 16;
            const bf16* kr = K + (size_t)(NCTX + b * LSEQ + rr * GWID + kc) * D + h * DH;
            for (int d = 0; d < DH; ++d) sc += sq[d] * bf2f(kr[d]);
            int dr = rr - r + 7, dc = kc - c + 15; dc = dc < 0 ? 0 : (dc > 30 ? 30 : dc);
            sc += rp[dr * 31 + dc] * LOG2E_F;
        } else { const bf16* kr = ck + (size_t)(i - 128) * D; for (int d = 0; d < DH; ++d) sc += sq[d] * bf2f(kr[d]); }
        sp[i] = sc; mx = fmaxf(mx, sc);
    }
    red[threadIdx.x] = mx; __syncthreads();
    for (int o = 128; o > 0; o >>= 1) { if (threadIdx.x < o) red[threadIdx.x] = fmaxf(red[threadIdx.x], red[threadIdx.x + o]); __syncthreads(); }
    mx = red[0]; __syncthreads();
    float ps = 0.f;
    for (int i = threadIdx.x; i < 128 + PAST; i += 256) { float p = exp2f(sp[i] - mx); sp[i] = p; ps += p; }
    red[threadIdx.x] = ps; __syncthreads();
    for (int o = 128; o > 0; o >>= 1) { if (threadIdx.x < o) red[threadIdx.x] += red[threadIdx.x + o]; __syncthreads(); }
    const float inv = 1.f / red[0];
    if (threadIdx.x < DH) { const int d = threadIdx.x; float o = 0.f;
        for (int i = 0; i < 128; ++i) { int rr = rs + i / 16, kc = qs + i % 16; o += sp[i] * bf2f(V[(size_t)(NCTX + b * LSEQ + rr * GWID + kc) * D + h * DH + d]); }
        for (int i = 0; i < PAST; ++i) o += sp[128 + i] * bf2f(cv[(size_t)i * D + d]);
        const size_t idx = (size_t)t * D + h * DH + d;
        Gb[idx] = (bf16)f2bf(o * inv * bf2f(SZ[idx])); }
}

extern "C" void kernel_launch(void* const* d_in, const int* in_sizes, int n_in, void* d_out, int out_size, void* d_ws, size_t ws_size, hipStream_t stream) {
    static int grid = 0;
    if (grid == 0) {
        int dev = 0, cus = 0, per_cu = 0;
        if (n_in != 19 || ws_size < WS_END) { fprintf(stderr, "kernel_launch: unexpected n_in %d / ws %zu\n", n_in, ws_size); grid = -1; return; }
        if (hipGetDevice(&dev) != hipSuccess || hipDeviceGetAttribute(&cus, hipDeviceAttributeMultiprocessorCount, dev) != hipSuccess) { grid = -1; return; }
        if (hipFuncSetAttribute((const void*)mk_fwd, hipFuncAttributeMaxDynamicSharedMemorySize, LDS_BYTES) != hipSuccess) { fprintf(stderr, "kernel_launch: hipFuncSetAttribute failed\n"); grid = -1; return; }
        if (hipOccupancyMaxActiveBlocksPerMultiprocessor(&per_cu, (const void*)mk_fwd, NTHR, LDS_BYTES) != hipSuccess || per_cu < 1) { fprintf(stderr, "kernel_launch: occupancy query says %d\n", per_cu); }
        (void)hipGetLastError();
        grid = cus;
    }
    if (grid < 0) return;
    (void)hipMemsetAsync((char*)d_ws + WS_CTL, 0, CTL_ZERO_BYTES, stream);
    Args a{};
    for (int i = 0; i < 19; ++i) a.in[i] = (const float*)d_in[i];
    a.out = (float*)d_out; a.ws = (unsigned char*)d_ws;
    unsigned char* ws = (unsigned char*)d_ws;
    bf16* G = (bf16*)(ws + WS_G); bf16* B0 = (bf16*)(ws + WS_B0); bf16* B1 = (bf16*)(ws + WS_B1); bf16* B2 = (bf16*)(ws + WS_B2); bf16* B3 = (bf16*)(ws + WS_B3);
    auto run = [&](int lo, int hi) { a.ph_lo = lo; a.ph_hi = hi; hipLaunchKernelGGL(mk_fwd, dim3(grid), dim3(NTHR), LDS_BYTES, stream, a); };
#if MK_ONE_LAUNCH
    run(0, N_PHASES);
#else
    for (int ph = 0; ph < N_PHASES; ++ph) run(ph, ph + 1);
#endif
    (void)G; (void)B0; (void)B1; (void)B2; (void)B3;
}
```

```cpp
#include <hip/hip_runtime.h>
#include <cstdio>
#include <cstdint>
namespace pg8 {
#define PG8_LAS __attribute__((address_space(3)))
typedef unsigned short bf16_t;
typedef short bf16x8 __attribute__((ext_vector_type(8)));
typedef float f32x4 __attribute__((ext_vector_type(4)));
typedef unsigned u32x4 __attribute__((ext_vector_type(4)));
constexpr int BM = 256, BK = 64, HALF = 128, HTB = HALF * BK * 2  , STAGE_BYTES = 8 * HTB, NXCD = 8, WGM = 8;

__host__ __device__ __forceinline__ int lds_byte(int r, int c) { const int st = (r >> 4) * 2 + (c >> 5), rr = r & 15, cc = c & 31, ob = rr * 64 + cc * 2; return st * 1024 + (ob ^ (((ob >> 9) & 1) << 5)); }
__host__ __device__ __forceinline__ void stage_rc(int b, int& R, int& C) { const int st = b / 1024, sb = b % 1024, swz = sb ^ (((sb >> 9) & 1) << 5); R = (st >> 1) * 16 + swz / 64; C = (st & 1) * 32 + (swz % 64) / 2; }
__host__ __device__ __forceinline__ int perm32(int rho) { const int n = rho >> 4, i = rho & 15; return 8 * (i >> 2) + 4 * n + (i & 3); }

struct Unit { int pm, pn; };
struct Gemm { const bf16_t* A; const bf16_t* Bt; int M, N, K; };

struct StaticOrder {
    int nM, nN, nwg, G, c;
    __host__ __device__ void init(int M, int N, int G_, int c_) { nM = M / BM; nN = N / BM; nwg = nM * nN; G = G_; c = c_; }
    __host__ __device__ bool next(int i, Unit& u) const {
        const long L = (long)i * G + c; if (L >= nwg) return false;
        int wgid = (int)L; { const int q = nwg / NXCD, r = nwg % NXCD, xcd = wgid % NXCD, off = wgid / NXCD; wgid = (xcd < r ? xcd * (q + 1) : r * (q + 1) + (xcd - r) * q) + off; }
        const int nig = WGM * nN, gid = wgid / nig, fm = gid * WGM, gsz = (nM - fm) < WGM ? (nM - fm) : WGM;
        u.pm = fm + ((wgid % nig) % gsz); u.pn = (wgid % nig) / gsz; return true;
    }
    __device__ __forceinline__ void a_ready(const Unit&) const {}
    __device__ __forceinline__ void done(const Unit&) const {}
};


__device__ __forceinline__ unsigned cvt_pk_bf16(float lo, float hi) { unsigned r; asm volatile("v_cvt_pk_bf16_f32 %0, %1, %2" : "=v"(r) : "v"(lo), "v"(hi)); return r; }
constexpr int ROWLEN = 1024;
constexpr int NTOKC = 4096;
constexpr float RMS_EPS = 1e-6f;
constexpr float LOG2E = 1.4426950408889634f;
constexpr float QSCALE = 0.125f * LOG2E;
__device__ __forceinline__ int mg_of_tile(int pm) { return pm < 16 ? 0 : 1 + ((pm - 16) >> 3); }
__device__ __forceinline__ int mg_of_row(int row) { return row < NTOKC ? 0 : 1 + ((row - NTOKC) >> 11); }
template <bool M192> __device__ __forceinline__ int frag_row(int pm, int ai, int m, int wr) { return M192 ? pm * 192 + (ai == 1 ? 128 + wr * 32 + m * 16 : wr * 64 + m * 16) : pm * BM + ai * HALF + wr * 64 + m * 16; }
__device__ __forceinline__ float fast_sigmoid(float x) { return __builtin_amdgcn_rcpf(1.0f + __builtin_amdgcn_exp2f(-LOG2E * x)); }
__device__ __forceinline__ f32x4 sigm4(f32x4 v) { return (f32x4){fast_sigmoid(v[0]), fast_sigmoid(v[1]), fast_sigmoid(v[2]), fast_sigmoid(v[3])}; }
__device__ __forceinline__ u32x4 pack8(f32x4 a, f32x4 b) { u32x4 w; w.x = cvt_pk_bf16(a[0], a[1]); w.y = cvt_pk_bf16(a[2], a[3]); w.z = cvt_pk_bf16(b[0], b[1]); w.w = cvt_pk_bf16(b[2], b[3]); return w; }
__device__ __forceinline__ float row_rscale(const float* ssp, int row) {
    const f32x4* p = (const f32x4*)(ssp + (size_t)row * 16);
    const f32x4 a = p[0], b = p[1], c = p[2], d = p[3];
    const f32x4 s = (a + b) + (c + d);
    return __builtin_amdgcn_rsqf(((s[0] + s[1]) + (s[2] + s[3])) * (1.0f / ROWLEN) + RMS_EPS);
}

template <bool M192> struct EpiConv1 {
    static constexpr bool PERM = true, AFTER_DRAIN = false;
    const float* ssp; const float* bias  ; bf16_t* U; bf16_t* SZ;
    __device__ __forceinline__ void operator()(const f32x4 (&acc)[2][2][4][2], const Unit& u, int wr, int wc, int fr, int fq) const {
        int mg = mg_of_row(frag_row<M192>(u.pm, 0, 0, wr));
        const float* bb0 = bias + u.pn * BM + wc * 32 + 8 * fq;
        f32x4 bv[2][2];
#pragma unroll
        for (int bj = 0; bj < 2; ++bj)
#pragma unroll
            for (int n = 0; n < 2; ++n) bv[bj][n] = *(const f32x4*)(bb0 + mg * 4096 + bj * HALF + 4 * n);
        const bool ab = u.pn < 8;
        const int col = ab ? u.pn * HALF + wc * 32 + 8 * fq : (u.pn - 8) * BM + wc * 32 + 8 * fq;
#pragma unroll
        for (int ai = 0; ai < 2; ++ai)
#pragma unroll
            for (int m = 0; m < ((M192 && ai == 1) ? 2 : 4); ++m) { const int rowb = frag_row<M192>(u.pm, ai, m, wr), row = rowb + fr; const float rs = row_rscale(ssp, row);
                if (M192) { const int mgr = mg_of_row(rowb); if (mgr != mg) { mg = mgr;
#pragma unroll
                        for (int bj = 0; bj < 2; ++bj)
#pragma unroll
                            for (int n = 0; n < 2; ++n) bv[bj][n] = *(const f32x4*)(bb0 + mg * 4096 + bj * HALF + 4 * n); } }
                if (ab) {
                    const f32x4 a0 = acc[ai][0][m][0] * rs + bv[0][0], a1 = acc[ai][0][m][1] * rs + bv[0][1];
                    const f32x4 b0 = acc[ai][1][m][0] * rs + bv[1][0], b1 = acc[ai][1][m][1] * rs + bv[1][1];
                    *(u32x4*)(U + (size_t)row * ROWLEN + col) = pack8(a0 * sigm4(b0), a1 * sigm4(b1));
                } else {
#pragma unroll
                    for (int bj = 0; bj < 2; ++bj) { const f32x4 z0 = acc[ai][bj][m][0] * rs + bv[bj][0], z1 = acc[ai][bj][m][1] * rs + bv[bj][1];
                        *(u32x4*)(SZ + (size_t)row * ROWLEN + col + bj * HALF) = pack8(z0 * sigm4(z0), z1 * sigm4(z1)); } } }
    }
};

struct EpiAttn1 {
    static constexpr bool PERM = true, AFTER_DRAIN = false;
    const float* ssp; const float* bias; bf16_t* B0; size_t bstride  ; float* newk; size_t nstride  ; int j;
    __device__ __forceinline__ void operator()(const f32x4 (&acc)[2][2][4][2], const Unit& u, int wr, int wc, int fr, int fq) const {
        const int mg = mg_of_tile(u.pm);
        const float* bb = bias + mg * 4096 + u.pn * BM + wc * 32 + 8 * fq;
        f32x4 bv[2][2];
#pragma unroll
        for (int bj = 0; bj < 2; ++bj)
#pragma unroll
            for (int n = 0; n < 2; ++n) bv[bj][n] = *(const f32x4*)(bb + bj * HALF + 4 * n);
        const int row0 = u.pm * BM + wr * 64 + fr;
        const int sect = u.pn >> 2, col = (u.pn & 3) * BM + wc * 32 + 8 * fq;
        const int bidx = sect == 0 ? 0 : (sect == 3 ? 1 : sect + 1);
        bf16_t* dst = B0 + (size_t)bidx * bstride;
        float* cdst = newk + (sect == 2 ? nstride : (size_t)0);
        const bool cache = (sect == 1 || sect == 2) && u.pm < 16;
        const float qs = sect == 0 ? QSCALE : 1.0f;
#pragma unroll
        for (int ai = 0; ai < 2; ++ai)
#pragma unroll
            for (int m = 0; m < 4; ++m) { const int row = row0 + ai * HALF + m * 16; const float rs = row_rscale(ssp, row);
#pragma unroll
                for (int bj = 0; bj < 2; ++bj) { f32x4 v0 = acc[ai][bj][m][0] * rs + bv[bj][0], v1 = acc[ai][bj][m][1] * rs + bv[bj][1];
                    if (cache) { float* cp = cdst + ((size_t)(u.pm * 2 + j) * 256 + (row - u.pm * BM)) * ROWLEN + col + bj * HALF; *(f32x4*)cp = v0; *(f32x4*)(cp + 4) = v1; }
                    v0 = v0 * qs; v1 = v1 * qs;
                    if (sect == 3) { v0 = v0 * sigm4(v0); v1 = v1 * sigm4(v1); }
                    *(u32x4*)(dst + (size_t)row * ROWLEN + col + bj * HALF) = pack8(v0, v1); } }
    }
};

template <bool HAS_NEXT, bool M192> struct EpiGemm2 {
    static constexpr bool PERM = true, AFTER_DRAIN = false;
    const float* base_ctx; const float* base_lat; float* out; const float* gate  ; int gate_stride; const float* gsn  ; bf16_t* XS; float* ssp;
    __device__ __forceinline__ void operator()(const f32x4 (&acc)[2][2][4][2], const Unit& u, int wr, int wc, int fr, int fq) const {
        int mg = mg_of_row(frag_row<M192>(u.pm, 0, 0, wr));
        const int col = u.pn * BM + wc * 32 + 8 * fq;
        f32x4 gv[2][2], sv[2][2];
#pragma unroll
        for (int bj = 0; bj < 2; ++bj)
#pragma unroll
            for (int n = 0; n < 2; ++n) { gv[bj][n] = *(const f32x4*)(gate + (size_t)mg * gate_stride + col + bj * HALF + 4 * n);
                if (HAS_NEXT) sv[bj][n] = *(const f32x4*)(gsn + mg * ROWLEN + col + bj * HALF + 4 * n); }
#pragma unroll
        for (int ai = 0; ai < 2; ++ai)
#pragma unroll
            for (int m = 0; m < ((M192 && ai == 1) ? 2 : 4); ++m) { const int rowb = frag_row<M192>(u.pm, ai, m, wr), row = rowb + fr; float sq = 0.f;
                if (M192) { const int mgr = mg_of_row(rowb); if (mgr != mg) { mg = mgr;
#pragma unroll
                        for (int bj = 0; bj < 2; ++bj)
#pragma unroll
                            for (int n = 0; n < 2; ++n) { gv[bj][n] = *(const f32x4*)(gate + (size_t)mg * gate_stride + col + bj * HALF + 4 * n);
                                if (HAS_NEXT) sv[bj][n] = *(const f32x4*)(gsn + mg * ROWLEN + col + bj * HALF + 4 * n); } } }
                const float* base = rowb < NTOKC ? base_ctx : base_lat - (size_t)NTOKC * ROWLEN;
#pragma unroll
                for (int bj = 0; bj < 2; ++bj) { const size_t off = (size_t)row * ROWLEN + col + bj * HALF;
                    const f32x4 x0 = *(const f32x4*)(base + off) + gv[bj][0] * acc[ai][bj][m][0], x1 = *(const f32x4*)(base + off + 4) + gv[bj][1] * acc[ai][bj][m][1];
                    *(f32x4*)(out + off) = x0; *(f32x4*)(out + off + 4) = x1;
                    sq += (x0[0] * x0[0] + x0[1] * x0[1]) + (x0[2] * x0[2] + x0[3] * x0[3]) + (x1[0] * x1[0] + x1[1] * x1[1]) + (x1[2] * x1[2] + x1[3] * x1[3]);
                    if (HAS_NEXT) *(u32x4*)(XS + off) = pack8(x0 * sv[bj][0], x1 * sv[bj][1]); }
                sq += __shfl_xor(sq, 16); sq += __shfl_xor(sq, 32);
                if (fq == 0) ssp[(size_t)row * 16 + u.pn * 4 + wc] = sq; }
    }
};
template <class Epi, class Sched, bool ALIGN_EPI = false, bool SP2 = false, bool M192 = false>
__device__ __forceinline__ void gemm_phase(PG8_LAS unsigned char* lds, const Gemm g, const Sched& S, const Epi& E) {
    int tid_ = threadIdx.x; asm volatile("" : "+v"(tid_));
    const int tid = tid_, wid = __builtin_amdgcn_readfirstlane(tid >> 6), lane = tid & 63, wr = wid >> 2, wc = wid & 3, fr = lane & 15, fq = lane >> 4;
    const int K = g.K, nt = K / BK;
    static_assert(!M192 || SP2, "M192 is wired into the SP2 loop only");
    unsigned voffA[2], voffA1[2], voffB[2];
#pragma unroll
    for (int i = 0; i < 2; ++i) { int R, C; stage_rc(tid * 16 + i * 8192, R, C); const int Rb = Epi::PERM ? ((R & ~31) + perm32(R & 31)) : R;
        const int R1 = M192 ? (R < 32 ? R : ((R >= 64 && R < 96) ? R - 32 : 0)) : R;
        voffA[i] = (unsigned)(R * K + C) * 2u; voffA1[i] = (unsigned)(R1 * K + C) * 2u; voffB[i] = (unsigned)(Rb * K + C) * 2u; }
    const size_t kstep = (size_t)(BK * 2);
    const size_t hstep = (size_t)HALF * K * 2;
    const size_t tstep = 2 * hstep;
    const size_t tstepA = M192 ? (size_t)192 * K * 2 : tstep;
    const unsigned ldsw = (unsigned)wid * 1024u;
    const int aoff = lds_byte(wr * 64 + fr, fq * 8), boff = lds_byte(wc * 32 + fr, fq * 8);
#define PG8_SA(b, h) (((b) * 2 + (h)) * HTB)
#define PG8_SB(b, h) ((4 + (b) * 2 + (h)) * HTB)
#define PG8_STAGE(bufoff, gbase, voff) do { _Pragma("unroll") for (int _i = 0; _i < 2; ++_i) \
        __builtin_amdgcn_global_load_lds((const unsigned*)((const char*)(gbase) + (voff)[_i]), (PG8_LAS unsigned*)(lds + (bufoff) + ldsw + _i * 8192), 16, 0, 0); } while (0)
#define PG8_LDA(dst, b, h) do { _Pragma("unroll") for (int m = 0; m < ((M192 && (h) == 1) ? 2 : 4); ++m) _Pragma("unroll") for (int k = 0; k < 2; ++k) dst[m][k] = *(const PG8_LAS bf16x8*)(lds + PG8_SA(b, h) + aoff + m * 2048 + k * 1024); } while (0)
#define PG8_LDB(dst, b, h) do { _Pragma("unroll") for (int n = 0; n < 2; ++n) _Pragma("unroll") for (int k = 0; k < 2; ++k) dst[n][k] = *(const PG8_LAS bf16x8*)(lds + PG8_SB(b, h) + boff + n * 2048 + k * 1024); } while (0)
#define PG8_MMA(ai, bj, At, Bt) do { __builtin_amdgcn_s_setprio(1); _Pragma("unroll") for (int m = 0; m < ((M192 && (ai) == 1) ? 2 : 4); ++m) _Pragma("unroll") for (int n = 0; n < 2; ++n) _Pragma("unroll") for (int k = 0; k < 2; ++k) \
        acc[ai][bj][m][n] = __builtin_amdgcn_mfma_f32_16x16x32_bf16(Bt[n][k], At[m][k], acc[ai][bj][m][n], 0, 0, 0); __builtin_amdgcn_s_setprio(0); } while (0)
#define PG8_WAIT_V(n) asm volatile("s_waitcnt vmcnt(" #n ")" ::: "memory")
#define PG8_WAIT_L(n) asm volatile("s_waitcnt lgkmcnt(" #n ")" ::: "memory")
#define PG8_BAR __builtin_amdgcn_s_barrier()
#define PG8_SCHED __builtin_amdgcn_sched_barrier(0)
    Unit cur, nxt; int ui = 0;
    if (!S.next(0, cur)) return;
    f32x4 acc[2][2][4][2];
#pragma unroll
    for (int a = 0; a < 2; ++a)
#pragma unroll
        for (int b = 0; b < 2; ++b)
#pragma unroll
            for (int m = 0; m < 4; ++m)
#pragma unroll
                for (int n = 0; n < 2; ++n) acc[a][b][m][n] = (f32x4){0.f, 0.f, 0.f, 0.f};
    bf16x8 At[4][2], B0[2][2], B1[2][2];
    const char* cA = (const char*)g.A + (size_t)cur.pm * tstepA; const char* cB = (const char*)g.Bt + (size_t)cur.pn * tstep;
    S.a_ready(cur);
    if constexpr (SP2) {
        PG8_STAGE(PG8_SB(0, 0), cB, voffB); PG8_STAGE(PG8_SB(0, 1), cB + hstep, voffB); PG8_STAGE(PG8_SA(0, 0), cA, voffA); PG8_STAGE(PG8_SA(0, 1), cA + hstep, voffA1);
        if (wr == 1) PG8_BAR;
        PG8_WAIT_V(2); PG8_BAR;
        PG8_STAGE(PG8_SB(1, 0), cB + kstep, voffB); PG8_STAGE(PG8_SA(1, 0), cA + kstep, voffA); PG8_STAGE(PG8_SB(1, 1), cB + hstep + kstep, voffB);
        PG8_WAIT_V(6); PG8_BAR;
    } else {
        PG8_STAGE(PG8_SB(0, 0), cB, voffB); PG8_STAGE(PG8_SA(0, 0), cA, voffA); PG8_STAGE(PG8_SB(0, 1), cB + hstep, voffB); PG8_STAGE(PG8_SA(0, 1), cA + hstep, voffA);
        if (wr == 1) PG8_BAR;
        PG8_WAIT_V(4); PG8_BAR;
        PG8_STAGE(PG8_SB(1, 0), cB + kstep, voffB); PG8_STAGE(PG8_SA(1, 0), cA + kstep, voffA); PG8_STAGE(PG8_SB(1, 1), cB + hstep + kstep, voffB);
        PG8_WAIT_V(6); PG8_BAR;
    }
    for (;;) {
        const bool has_next = S.next(ui + 1, nxt);
        const char* nA = has_next ? (const char*)g.A + (size_t)nxt.pm * tstepA : cA; const char* nB = has_next ? (const char*)g.Bt + (size_t)nxt.pn * tstep : cB;
        for (int t = 0; t < nt; t += 2) {
            const bool last = (t == nt - 2);
            const char* a1 = cA + (size_t)(t + 1) * kstep;
            const char* a2 = last ? nA : cA + (size_t)(t + 2) * kstep; const char* b2 = last ? nB : cB + (size_t)(t + 2) * kstep;
            const char* a3 = a2 + kstep; const char* b3 = b2 + kstep;
            if (last && has_next) S.a_ready(nxt);
            if constexpr (SP2) {
            PG8_LDB(B0, 0, 0); PG8_LDB(B1, 0, 1); PG8_SCHED; PG8_LDA(At, 0, 0); PG8_STAGE(PG8_SA(1, 1), a1 + hstep, voffA1);
            PG8_WAIT_V(8); PG8_WAIT_L(0); PG8_BAR; PG8_MMA(0, 0, At, B0); PG8_MMA(0, 1, At, B1); PG8_BAR; PG8_SCHED;
            PG8_LDA(At, 0, 1); PG8_STAGE(PG8_SB(0, 0), b2, voffB); PG8_STAGE(PG8_SB(0, 1), b2 + hstep, voffB); PG8_STAGE(PG8_SA(0, 0), a2, voffA);
            PG8_WAIT_V(8); PG8_WAIT_L(0); PG8_BAR; PG8_MMA(1, 0, At, B0); PG8_MMA(1, 1, At, B1); PG8_BAR; PG8_SCHED;
            PG8_LDB(B0, 1, 0); PG8_LDB(B1, 1, 1); PG8_SCHED; PG8_LDA(At, 1, 0); PG8_STAGE(PG8_SA(0, 1), a2 + hstep, voffA1);
            PG8_WAIT_V(8); PG8_WAIT_L(0); PG8_BAR; PG8_MMA(0, 0, At, B0); PG8_MMA(0, 1, At, B1); PG8_BAR; PG8_SCHED;
            PG8_LDA(At, 1, 1); PG8_STAGE(PG8_SB(1, 0), b3, voffB); PG8_STAGE(PG8_SB(1, 1), b3 + hstep, voffB); PG8_STAGE(PG8_SA(1, 0), a3, voffA);
            PG8_WAIT_V(8); PG8_WAIT_L(0); PG8_BAR; PG8_MMA(1, 0, At, B0); PG8_MMA(1, 1, At, B1); PG8_BAR; PG8_SCHED;
            } else {
            PG8_LDB(B0, 0, 0); PG8_SCHED; PG8_LDA(At, 0, 0); PG8_STAGE(PG8_SA(1, 1), a1 + hstep, voffA);
            PG8_WAIT_L(8); PG8_BAR; PG8_WAIT_L(0); PG8_MMA(0, 0, At, B0); PG8_BAR; PG8_SCHED;
            PG8_LDB(B1, 0, 1); PG8_STAGE(PG8_SB(0, 0), b2, voffB);
            PG8_BAR; PG8_WAIT_L(0); PG8_MMA(0, 1, At, B1); PG8_BAR;
            PG8_LDA(At, 0, 1); PG8_STAGE(PG8_SA(0, 0), a2, voffA);
            PG8_BAR; PG8_WAIT_L(0); PG8_MMA(1, 0, At, B0); PG8_BAR; PG8_SCHED;
            PG8_STAGE(PG8_SB(0, 1), b2 + hstep, voffB);
            PG8_WAIT_V(6); PG8_BAR; PG8_MMA(1, 1, At, B1); PG8_BAR;
            PG8_LDB(B0, 1, 0); PG8_SCHED; PG8_LDA(At, 1, 0); PG8_STAGE(PG8_SA(0, 1), a2 + hstep, voffA);
            PG8_WAIT_L(8); PG8_BAR; PG8_WAIT_L(0); PG8_MMA(0, 0, At, B0); PG8_BAR; PG8_SCHED;
            PG8_LDB(B1, 1, 1); PG8_STAGE(PG8_SB(1, 0), b3, voffB);
            PG8_BAR; PG8_WAIT_L(0); PG8_MMA(0, 1, At, B1); PG8_BAR;
            PG8_LDA(At, 1, 1); PG8_STAGE(PG8_SA(1, 0), a3, voffA);
            PG8_BAR; PG8_WAIT_L(0); PG8_MMA(1, 0, At, B0); PG8_BAR; PG8_SCHED;
            PG8_STAGE(PG8_SB(1, 1), b3 + hstep, voffB);
            PG8_WAIT_V(6); PG8_BAR; PG8_MMA(1, 1, At, B1); PG8_BAR;
            }
        }
        if constexpr (ALIGN_EPI) { if (wr == 0) PG8_BAR; }
        if constexpr (!Epi::AFTER_DRAIN) { E(acc, cur, wr, wc, fr, fq); S.done(cur); }
        if (!has_next) break;
#pragma unroll
        for (int a = 0; a < 2; ++a)
#pragma unroll
            for (int b = 0; b < 2; ++b)
#pragma unroll
                for (int m = 0; m < 4; ++m)
#pragma unroll
                    for (int n = 0; n < 2; ++n) acc[a][b][m][n] = (f32x4){0.f, 0.f, 0.f, 0.f};
        cur = nxt; cA = nA; cB = nB; ++ui;
        if constexpr (ALIGN_EPI) { if (wr == 1) PG8_BAR; }
    }
    PG8_WAIT_V(0);
    if constexpr (!ALIGN_EPI) { if (wr == 0) PG8_BAR; }
    PG8_BAR;
    if constexpr (Epi::AFTER_DRAIN) { E.fused(acc, cur, wr, wc, fr, fq, lds, wid, lane); S.done(cur); }
#undef PG8_SA
#undef PG8_SB
#undef PG8_STAGE
#undef PG8_LDA
#undef PG8_LDB
#undef PG8_MMA
#undef PG8_WAIT_V
#undef PG8_WAIT_L
#undef PG8_BAR
#undef PG8_SCHED
}
}
#define GAS __attribute__((address_space(1)))
#define LAS __attribute__((address_space(3)))
typedef unsigned short bf16;
typedef unsigned v4u __attribute__((ext_vector_type(4)));
typedef float f32x4 __attribute__((ext_vector_type(4)));
typedef short bf16x8 __attribute__((ext_vector_type(8)));
typedef GAS unsigned gu32;
typedef GAS unsigned long long gu64;
#define RLX_AGENT __ATOMIC_RELAXED, __HIP_MEMORY_SCOPE_AGENT
#define LDS_WAIT() asm volatile("s_waitcnt lgkmcnt(0)" ::: "memory")
#define VM_WAIT() asm volatile("s_waitcnt vmcnt(0)" ::: "memory")
__device__ __forceinline__ unsigned long long rt() { return __builtin_amdgcn_s_memrealtime(); }
__device__ __forceinline__ unsigned f2bf(float f) { unsigned u = __builtin_bit_cast(unsigned, f); return (u + 0x7fffu + ((u >> 16) & 1u)) >> 16; }
__device__ __forceinline__ unsigned pk2(float lo, float hi) { return f2bf(lo) | (f2bf(hi) << 16); }

#define XB_TMO      128
#define XB_XCNT(j)  (256  + 64 * (j))
#define XB_XSUB(j)  (1280 + 64 * (j))
#define XB_XGEN(j)  (2304 + 64 * (j))
#define XB_TOP      3328
#define XB_TOPGEN   3392
#define XCD_BAR_WORDS 3456
#define XB_SPIN_CAP (1u << 18)

__device__ __forceinline__ unsigned xb_ld(unsigned* p)              { return __hip_atomic_load(p, __ATOMIC_RELAXED, __HIP_MEMORY_SCOPE_AGENT); }
__device__ __forceinline__ unsigned xb_add(unsigned* p, unsigned v) { return __hip_atomic_fetch_add(p, v, __ATOMIC_RELAXED, __HIP_MEMORY_SCOPE_AGENT); }
__device__ __forceinline__ unsigned xb_xcc_id() { return (unsigned)__builtin_amdgcn_s_getreg((3 << 11) | 20) & 0xFu; }
#define XB_SPIN(cond, bar) do { unsigned _sp = 0; while (cond) { __builtin_amdgcn_s_sleep(1); \
    if ((++_sp & 255u) == 0u) { if (xb_ld(&(bar)[XB_TMO])) break; if (_sp > XB_SPIN_CAP) { atomicAdd(&(bar)[XB_TMO], 1u); break; } } } } while (0)

struct XcdBarrier {
    unsigned* bar; unsigned x;
    volatile LAS unsigned* st;
};

__device__ __forceinline__ XcdBarrier xcd_barrier_post(unsigned* bar, volatile LAS unsigned* st) {
    XcdBarrier b; b.bar = bar; b.x = xb_xcc_id(); b.st = st;
    if (threadIdx.x == 0) (void)xb_add(&bar[XB_XCNT(b.x)], 1u);
    return b;
}
__device__ __forceinline__ void xcd_barrier_complete(unsigned* bar, unsigned x, unsigned& nloc, unsigned& nx) {
    const unsigned G = gridDim.x * gridDim.y * gridDim.z;
    unsigned sum, cnt, mine, sp = 0u;
    for (;;) {
        sum = 0u; cnt = 0u; mine = 0u;
#pragma unroll
        for (unsigned j = 0; j < 16; ++j) { const unsigned c = xb_ld(&bar[XB_XCNT(j)]); sum += c; cnt += (c > 0u) ? 1u : 0u; mine = (j == x) ? c : mine; }
        if (sum == G) break;
        __builtin_amdgcn_s_sleep(1);
        if ((++sp & 255u) == 0u) { if (xb_ld(&bar[XB_TMO])) break; if (sp > XB_SPIN_CAP) { atomicAdd(&bar[XB_TMO], 1u); break; } }
    }
    nloc = mine > 0u ? mine : 1u; nx = cnt > 0u ? cnt : 1u;
}

__device__ __forceinline__ void xcd_barrier(const XcdBarrier& b) {
    asm volatile("s_waitcnt vmcnt(0)" ::: "memory");
    __syncthreads();
    if (threadIdx.x == 0) {
        unsigned* bar = b.bar;
        __builtin_amdgcn_s_waitcnt(0);
        unsigned nloc = b.st[0], nx = b.st[1];
        if (nloc == 0u) { xcd_barrier_complete(bar, b.x, nloc, nx); b.st[0] = nloc; b.st[1] = nx; }
        const unsigned old = xb_add(&bar[XB_XSUB(b.x)], 1u);
        const unsigned gen = old / nloc;
        if (old + 1u == (gen + 1u) * nloc) {
            __builtin_amdgcn_fence(__ATOMIC_RELEASE, "agent");
            asm volatile("s_waitcnt vmcnt(0)" ::: "memory");
            const unsigned og = xb_add(&bar[XB_TOP], 1u);
            const unsigned tg = og / nx;
            if (og + 1u == (tg + 1u) * nx) xb_add(&bar[XB_TOPGEN], 1u);
            else XB_SPIN(xb_ld(&bar[XB_TOPGEN]) == tg, bar);
            __builtin_amdgcn_fence(__ATOMIC_ACQUIRE, "agent");
            xb_add(&bar[XB_XGEN(b.x)], 1u);
            asm volatile("s_waitcnt vmcnt(0)" ::: "memory");
        } else {
            XB_SPIN(xb_ld(&bar[XB_XGEN(b.x)]) == gen, bar);
            __builtin_amdgcn_fence(__ATOMIC_ACQUIRE, "agent");
            asm volatile("s_waitcnt vmcnt(0)" ::: "memory");
        }
    }
    __syncthreads();
}

constexpr int NWAVES = 8, NTHR = NWAVES * 64;
constexpr int D = 1024, NCTX_B = 16, SEQ = 256, DEPTH = 4, NLAT_B = 4, LSEQ = 2048, PAST = 512;
constexpr int NCTX = NCTX_B * SEQ, NLAT = NLAT_B * LSEQ, NTOK = NCTX + NLAT;
constexpr int GWID = 64, NH = 16, DH = 64, CK = 31, NMG = 5;
constexpr float EPS = 1e-6f;
constexpr float LOG2E_F = 1.4426950408889634f;

constexpr size_t MiB = 1u << 20;
constexpr size_t WS_CTL = 0, CTL_ZERO_BYTES = 64 * 1024;
constexpr int CW_BAR = 4096;
constexpr size_t WS_MOD = 1 * MiB;
constexpr size_t WS_GS = WS_MOD + 256 * 1024;
constexpr size_t WS_BIAS = WS_MOD + 512 * 1024;
constexpr size_t WS_SSP = 2 * MiB;
constexpr size_t WS_WCI = 4 * MiB;
constexpr size_t WS_WCO = WS_WCI + 2 * (size_t)3072 * 1024 * 2;
constexpr size_t WS_WNI = WS_WCO + 2 * (size_t)1024 * 1024 * 2;
constexpr size_t WS_WNO = WS_WNI + 2 * (size_t)4096 * 1024 * 2;
constexpr size_t WS_CKB = 44 * MiB;
constexpr size_t WS_CVB = WS_CKB + (size_t)NLAT_B * 2 * PAST * D * 2;
constexpr size_t ACT_BYTES = (size_t)NTOK * D * 2;
constexpr size_t WS_XS = 64 * MiB, WS_G = 88 * MiB, WS_B0 = 112 * MiB, WS_B1 = 136 * MiB, WS_B2 = 160 * MiB, WS_B3 = 184 * MiB, WS_END = 208 * MiB;
static_assert(WS_WNO + 2 * (size_t)1024 * 1024 * 2 <= WS_CKB && WS_CVB + (size_t)NLAT_B * 2 * PAST * D * 2 <= WS_XS && ACT_BYTES <= 24 * MiB, "d_ws map");

constexpr int RING_OFF = 0, RING_BYTES = 131072;
constexpr int LDSCTL_OFF = RING_BYTES, MISC_OFF = LDSCTL_OFF + 320;
constexpr int LDS_BYTES = 147456;

struct Args {
    const float* in[19]; float* out; unsigned char* ws; int ph_lo, ph_hi;
};

struct Frame {
    LAS unsigned char* lds; volatile LAS unsigned* MISC; gu32* ctl;
    int tid, lane, wave, vcu, G;
};

__device__ __forceinline__ int opaque(int x) { asm volatile("" : "+v"(x)); return x; }
__device__ __forceinline__ float wave_sum(float v) {
#pragma unroll
    for (int o = 1; o < 64; o <<= 1) v += __shfl_xor(v, o);
    return v;
}
__device__ __forceinline__ float bf2f(unsigned short b) { return __builtin_bit_cast(float, (unsigned)b << 16); }
__device__ __forceinline__ float bflo(unsigned w) { return __builtin_bit_cast(float, w << 16); }
__device__ __forceinline__ float bfhi(unsigned w) { return __builtin_bit_cast(float, w & 0xffff0000u); }
__device__ __forceinline__ float silu_f(float x) { return x * __builtin_amdgcn_rcpf(1.0f + __builtin_amdgcn_exp2f(-LOG2E_F * x)); }

__device__ __forceinline__ void transpose_item(const float* W, int K, int N, bf16* WT, int k0, int n0, int dst_row0, LAS float* scr, int lane) {
#pragma unroll 8
    for (int i = 0; i < 32; ++i) { const int kk = 2 * i + (lane >> 5); scr[kk * 33 + (lane & 31)] = W[(size_t)(k0 + kk) * N + n0 + (lane & 31)]; }
    LDS_WAIT(); asm volatile("" ::: "memory");
    const int c = lane & 7;
#pragma unroll
    for (int j = 0; j < 4; ++j) { const int n = (lane >> 3) + 8 * j; const LAS float* s = scr + (8 * c) * 33 + n;
        v4u o; o.x = pk2(s[0 * 33], s[1 * 33]); o.y = pk2(s[2 * 33], s[3 * 33]); o.z = pk2(s[4 * 33], s[5 * 33]); o.w = pk2(s[6 * 33], s[7 * 33]);
        *(GAS v4u*)(WT + (size_t)(dst_row0 + n) * K + k0 + 8 * c) = o; }
    LDS_WAIT(); asm volatile("" ::: "memory");
}
__device__ __forceinline__ int conv_in_row(int n) { return n < 1024 ? ((n >> 7) * 256 + (n & 127)) : (n < 2048 ? (((n - 1024) >> 7) * 256 + 128 + (n & 127)) : n); }

__device__ __forceinline__ void phase_p0a(Frame& F, const Args& a) {
    const float* c = a.in[2]; const float* cache_k = a.in[3]; const float* cache_v = a.in[4]; const float* c_ctx = a.in[5];
    const float* ada_w = a.in[7]; const float* ada_b = a.in[8];
    float* mod = (float*)(a.ws + WS_MOD);
    {
        LAS float* sc = (LAS float*)(F.lds);
        LAS float* red = (LAS float*)(F.lds + 20480);
        for (int i = F.tid; i < NMG * D; i += NTHR) { const int v = i >> 10, k = i & 1023; const float x = v == 0 ? c_ctx[k] : c[(v - 1) * D + k]; sc[i] = silu_f(x); }
        __syncthreads();
        for (int it = blockIdx.x; it < DEPTH * 48; it += F.G) {
            const int layer = it / 48, n0 = (it % 48) * 64;
            const float* w = ada_w + (size_t)layer * D * 3 * D + n0 + F.lane;
            float acc[NMG] = {0.f, 0.f, 0.f, 0.f, 0.f};
            const int kb = F.wave * 128;
#pragma unroll 8
            for (int k = 0; k < 128; ++k) { const float wv = w[(size_t)(kb + k) * 3 * D];
#pragma unroll
                for (int v = 0; v < NMG; ++v) acc[v] += sc[v * D + kb + k] * wv; }
#pragma unroll
            for (int v = 0; v < NMG; ++v) red[(F.wave * NMG + v) * 64 + F.lane] = acc[v];
            __syncthreads();
            if (F.tid < NMG * 64) { const int v = F.tid >> 6, l = F.tid & 63; float s = 0.f;
#pragma unroll
                for (int w8 = 0; w8 < 8; ++w8) s += red[(w8 * NMG + v) * 64 + l];
                mod[((size_t)v * DEPTH + layer) * 3 * D + n0 + l] = s + ada_b[layer * 3 * D + n0 + l]; }
            __syncthreads();
        }
        __syncthreads();
    }
    {
        LAS float* scr = (LAS float*)(F.lds + F.wave * 16384);
        const int gw = F.vcu * NWAVES + F.wave, NGW = F.G * NWAVES;
        constexpr int I_CI = 16 * 96, I_CO = 16 * 32, I_NI = 16 * 128, I_NO = 16 * 32;
        constexpr int NITEMS = 2 * (I_CI + I_CO + I_NI + I_NO);
        for (int it = gw; it < NITEMS; it += NGW) {
            int r = it;
            if (r < 2 * I_CI) { const int j = r / I_CI; r %= I_CI; const int kb = r / 96, nb = r % 96;
                transpose_item(a.in[9] + (size_t)j * D * 3072, D, 3072, (bf16*)(a.ws + WS_WCI) + (size_t)j * 3072 * D, kb * 64, nb * 32, conv_in_row(nb * 32), scr, F.lane); continue; }
            r -= 2 * I_CI;
            if (r < 2 * I_CO) { const int j = r / I_CO; r %= I_CO; const int kb = r / 32, nb = r % 32;
                transpose_item(a.in[14] + (size_t)j * D * D, D, D, (bf16*)(a.ws + WS_WCO) + (size_t)j * D * D, kb * 64, nb * 32, nb * 32, scr, F.lane); continue; }
            r -= 2 * I_CO;
            if (r < 2 * I_NI) { const int j = r / I_NI; r %= I_NI; const int kb = r / 128, nb = r % 128;
                transpose_item(a.in[15] + (size_t)j * D * 4096, D, 4096, (bf16*)(a.ws + WS_WNI) + (size_t)j * 4096 * D, kb * 64, nb * 32, nb * 32, scr, F.lane); continue; }
            r -= 2 * I_NI;
            { const int j = r / I_NO; r %= I_NO; const int kb = r / 32, nb = r % 32;
                transpose_item(a.in[17] + (size_t)j * D * D, D, D, (bf16*)(a.ws + WS_WNO) + (size_t)j * D * D, kb * 64, nb * 32, nb * 32, scr, F.lane); }
        }
        constexpr int CITEMS = NLAT_B * 2 * PAST * D / 512;
        for (int it = gw; it < 2 * CITEMS; it += NGW) {
            const bool isv = it >= CITEMS; const int r = isv ? it - CITEMS : it;
            const float* src = (isv ? cache_v : cache_k) + (size_t)r * 512 + F.lane * 8;
            bf16* dst = (bf16*)(a.ws + (isv ? WS_CVB : WS_CKB)) + (size_t)r * 512 + F.lane * 8;
            const f32x4 x0 = *(const f32x4*)src, x1 = *(const f32x4*)(src + 4);
            v4u o; o.x = pk2(x0[0], x0[1]); o.y = pk2(x0[2], x0[3]); o.z = pk2(x1[0], x1[1]); o.w = pk2(x1[2], x1[3]);
            *(v4u*)dst = o;
        }
    }
}

__device__ __forceinline__ void phase_p0b(Frame& F, const Args& a) {
    const float* mod = (const float*)(a.ws + WS_MOD); const float* norm_g = a.in[6];
    float* GS = (float*)(a.ws + WS_GS); float* BIAS = (float*)(a.ws + WS_BIAS); float* ssp = (float*)(a.ws + WS_SSP);
    bf16* XS = (bf16*)(a.ws + WS_XS);
    const int gw = F.vcu * NWAVES + F.wave, NGW = F.G * NWAVES;
    for (int i = (blockIdx.x * NTHR + F.tid); i < DEPTH * NMG * D; i += F.G * NTHR) { const int layer = i / (NMG * D), mg = (i / D) % NMG, k = i % D;
        GS[i] = norm_g[layer * D + k] * (1.0f + mod[((size_t)mg * DEPTH + layer) * 3 * D + D + k]); }
    for (int t = gw; t < NTOK; t += NGW) {
        const float* xr = t < NCTX ? a.in[0] + (size_t)t * D : a.in[1] + (size_t)(t - NCTX) * D;
        const int mg = t < NCTX ? 0 : 1 + (t - NCTX) / LSEQ;
        const float* sc = mod + ((size_t)mg * DEPTH + 0) * 3 * D + D; const float* ng = norm_g;
        float s = 0.f;
#pragma unroll
        for (int jj = 0; jj < 4; ++jj) { const int k = jj * 256 + F.lane * 4; const f32x4 v = *(const f32x4*)(xr + k); const f32x4 g4 = *(const f32x4*)(ng + k); const f32x4 s4 = *(const f32x4*)(sc + k);
            s += (v[0] * v[0] + v[1] * v[1]) + (v[2] * v[2] + v[3] * v[3]);
            const f32x4 o = v * g4 * (s4 + 1.0f);
            unsigned long long w = (unsigned long long)pk2(o[0], o[1]) | ((unsigned long long)pk2(o[2], o[3]) << 32);
            *(unsigned long long*)(XS + (size_t)t * D + k) = w; }
        s = wave_sum(s);
        if (F.lane < 16) ssp[(size_t)t * 16 + F.lane] = F.lane == 0 ? s : 0.f;
    }
    {
        LAS float* sh = (LAS float*)F.lds;
        int cur_layer = -1;
        for (int it = blockIdx.x; it < 224; it += F.G) {
            int layer, chunk; if (it < 48) { layer = 0; chunk = it; } else if (it < 112) { layer = 1; chunk = it - 48; } else if (it < 160) { layer = 2; chunk = it - 112; } else { layer = 3; chunk = it - 160; }
            if (layer != cur_layer) { __syncthreads();
                for (int i = F.tid; i < NMG * D; i += NTHR) sh[i] = mod[((size_t)(i >> 10) * DEPTH + layer) * 3 * D + (i & 1023)];
                cur_layer = layer; __syncthreads(); }
            const bf16* WT = (layer & 1) ? (const bf16*)(a.ws + WS_WNI) + (size_t)(layer >> 1) * 4096 * D : (const bf16*)(a.ws + WS_WCI) + (size_t)(layer >> 1) * 3072 * D;
            for (int rr = 0; rr < 8; ++rr) { const int n = chunk * 64 + F.wave * 8 + rr;
                const v4u w0 = *(const v4u*)(WT + (size_t)n * D + F.lane * 16), w1 = *(const v4u*)(WT + (size_t)n * D + F.lane * 16 + 8);
                float wf[16] = {bflo(w0.x), bfhi(w0.x), bflo(w0.y), bfhi(w0.y), bflo(w0.z), bfhi(w0.z), bflo(w0.w), bfhi(w0.w),
                                bflo(w1.x), bfhi(w1.x), bflo(w1.y), bfhi(w1.y), bflo(w1.z), bfhi(w1.z), bflo(w1.w), bfhi(w1.w)};
#pragma unroll
                for (int v = 0; v < NMG; ++v) { float s = 0.f;
#pragma unroll
                    for (int q = 0; q < 16; ++q) s += wf[q] * sh[v * D + F.lane * 16 + q];
                    s = wave_sum(s);
                    if (F.lane == 0) BIAS[((size_t)layer * NMG + v) * 4096 + n] = s; } }
        }
    }
}


constexpr int CONV_TT = 16, CONV_ROWS = CONV_TT + CK - 1, CONV_CHUNK = 48;
__device__ __forceinline__ void phase_conv(Frame& F, const Args& a, int j) {
    const bf16* U = (const bf16*)(a.ws + WS_B0); const bf16* SZ = (const bf16*)(a.ws + WS_B1); bf16* Gb = (bf16*)(a.ws + WS_G);
    const float* dw_w = a.in[10] + (size_t)j * CK * D; const float* dw_b = a.in[11] + j * D; const float* ln_g = a.in[12] + j * D; const float* ln_b = a.in[13] + j * D;
    const int tid = opaque(F.tid), lane = tid & 63;
    typedef float f32x2 __attribute__((ext_vector_type(2)));
    f32x2 w[CK];
#pragma unroll
    for (int k = 0; k < CK; ++k) w[k] = *(const f32x2*)(dw_w + k * D + 2 * tid);
    const f32x2 cb = *(const f32x2*)(dw_b + 2 * tid), lg = *(const f32x2*)(ln_g + 2 * tid), lb = *(const f32x2*)(ln_b + 2 * tid);
    const __amdgpu_buffer_rsrc_t rsz = __builtin_amdgcn_make_buffer_rsrc((void*)SZ, (short)0, (int)ACT_BYTES, 0x00020000);
    const __amdgpu_buffer_rsrc_t rg = __builtin_amdgcn_make_buffer_rsrc((void*)Gb, (short)0, (int)ACT_BYTES, 0x00020000);
    LAS unsigned char* rows = F.lds;
    LAS float* red = (LAS float*)(F.lds + RING_BYTES + 512);
    LAS float* stats = red + 256;
    constexpr int CONV_ZROW = 65;
    *(LAS unsigned*)(rows + CONV_ZROW * 2048 + tid * 4) = 0u;
    for (int chunk = blockIdx.x; chunk < NTOK / CONV_CHUNK; chunk += F.G) {
        const int T0 = chunk * CONV_CHUNK;
        for (int q = tid; q < CONV_ROWS * 128; q += NTHR) { const int row = q >> 7, ch = q & 127; int tok = T0 - (CK / 2) + row; tok = tok < 0 ? 0 : tok;
            *(LAS v4u*)(rows + row * 2048 + ch * 16) = *(const v4u*)(U + (size_t)tok * D + ch * 8); }
        __syncthreads();
#pragma unroll 1
        for (int i = 0; i < CONV_CHUNK / CONV_TT; ++i) {
            const int t0 = T0 + CONV_TT * i;
            int s0, len; if (t0 < NCTX) { s0 = (t0 / SEQ) * SEQ; len = SEQ; } else { s0 = NCTX + ((t0 - NCTX) / LSEQ) * LSEQ; len = LSEQ; }
            v4u pre[4];
            const bool has_next = i + 1 < CONV_CHUNK / CONV_TT;
            if (has_next) {
#pragma unroll
                for (int e = 0; e < 4; ++e) { const int q = tid + e * NTHR, row = q >> 7, ch = q & 127; int tok = T0 - (CK / 2) + CONV_TT * i + CONV_ROWS + row; tok = tok > NTOK - 1 ? NTOK - 1 : tok;
                    pre[e] = *(const v4u*)(U + (size_t)tok * D + ch * 8); } }
            f32x2 o[CONV_TT];
#pragma unroll
            for (int l = 0; l < CONV_TT; ++l) o[l] = cb;
            int tb = tid * 4;
#pragma unroll
            for (int r = 0; r < CONV_ROWS; ++r) { const int tok = t0 - (CK / 2) + r;
                if ((r & 3) == 0) asm volatile("" : "+v"(tb));
                {
                    const int slot = (tok >= s0 && tok < s0 + len) ? ((CONV_TT * i + r) & 63) : CONV_ZROW;
                    const unsigned uw = *(const LAS unsigned*)(rows + slot * 2048 + tb); const f32x2 u2 = {bflo(uw), bfhi(uw)};
#pragma unroll
                    for (int l = 0; l < CONV_TT; ++l) { const int k = r - l; if (k >= 0 && k < CK) o[l] += u2 * w[k]; } }
                if ((r & 3) == 3) asm volatile("" ::: "memory"); }
            if (has_next) {
#pragma unroll
                for (int e = 0; e < 4; ++e) { const int q = tid + e * NTHR, row = q >> 7, ch = q & 127; *(LAS v4u*)(rows + ((CONV_TT * i + CONV_ROWS + row) & 63) * 2048 + ch * 16) = pre[e]; } }
            unsigned szw[CONV_TT];
#pragma unroll
            for (int l = 0; l < CONV_TT; ++l) szw[l] = __builtin_amdgcn_raw_buffer_load_b32(rsz, tid * 4, (t0 + l) * (D * 2), 0);
            float v[32];
#pragma unroll
            for (int l = 0; l < CONV_TT; ++l) { v[l] = o[l].x + o[l].y; v[16 + l] = o[l].x * o[l].x + o[l].y * o[l].y; }
#pragma unroll
            for (int s = 0; s < 5; ++s) { const int hn = 16 >> s; const unsigned upm = 0u - ((unsigned)(lane >> s) & 1u);
#pragma unroll
                for (int ii = 0; ii < hn; ++ii) { const unsigned a_ = __float_as_uint(v[ii]), b_ = __float_as_uint(v[ii + hn]);
                    const float keep = __uint_as_float((b_ & upm) | (a_ & ~upm)), send = __uint_as_float((a_ & upm) | (b_ & ~upm)); v[ii] = keep + __shfl_xor(send, 1 << s); } }
            v[0] += __shfl_xor(v[0], 32);
            if (lane < 32) { const int idx = ((lane & 1) << 4) | ((lane & 2) << 2) | (lane & 4) | ((lane & 8) >> 2) | ((lane & 16) >> 4); red[F.wave * 32 + idx] = v[0]; }
            __syncthreads();
            if (tid < 32) { float ss = 0.f;
#pragma unroll
                for (int w8 = 0; w8 < 8; ++w8) ss += red[w8 * 32 + tid];
                stats[tid] = ss; }
            __syncthreads();
#pragma unroll
            for (int l = 0; l < CONV_TT; ++l) { const float mu = stats[l] * (1.0f / D); const float var = stats[16 + l] * (1.0f / D) - mu * mu; const float rstd = __builtin_amdgcn_rsqf(var + EPS);
                const float y0 = (o[l].x - mu) * rstd * lg.x + lb.x, y1 = (o[l].y - mu) * rstd * lg.y + lb.y;
                __builtin_amdgcn_raw_buffer_store_b32(pk2(silu_f(y0) * bflo(szw[l]), silu_f(y1) * bfhi(szw[l])), rg, tid * 4, (t0 + l) * (D * 2), 0); }
        }
        __syncthreads();
    }
}

namespace att {
typedef float f32x16 __attribute__((ext_vector_type(16)));
typedef short s16x4 __attribute__((ext_vector_type(4)));
constexpr int SLOT = 16384, KOFF = 0, VOFF = 8192, NSLOT = 4;
constexpr int TBL_OFF = NSLOT * SLOT, TBL_STRIDE = 80  , WSF_OFF = TBL_OFF + 6144, STG_ROW = 272  ;
constexpr float THR = 8.0f, NEG = -1.0e30f;
#ifndef ATT_PINGPONG
#define ATT_PINGPONG 0
#endif
__device__ __forceinline__ int crow(int r, int hi) { return (r & 3) + 8 * (r >> 2) + 4 * hi; }
__device__ __forceinline__ unsigned cvtpk(float lo, float hi) { unsigned r; asm volatile("v_cvt_pk_bf16_f32 %0, %1, %2" : "=v"(r) : "v"(lo), "v"(hi)); return r; }
__device__ __forceinline__ s16x4 vtr(const LAS unsigned char* p) { return __builtin_bit_cast(s16x4, __builtin_amdgcn_ds_read_tr16_b64_v4i16((LAS s16x4*)p)); }
__device__ __forceinline__ float swapmax(float m) { auto rr = __builtin_amdgcn_permlane32_swap(__float_as_uint(m), __float_as_uint(m), false, false); return fmaxf(__uint_as_float(rr[0]), __uint_as_float(rr[1])); }
__device__ __forceinline__ float swapadd(float m) { auto rr = __builtin_amdgcn_permlane32_swap(__float_as_uint(m), __float_as_uint(m), false, false); return __uint_as_float(rr[0]) + __uint_as_float(rr[1]); }
struct Params { const bf16 *Q, *K, *V, *SZ, *CK, *CV; bf16* G; const float* rpb; int j; };
__device__ __forceinline__ bf16x8 packp(const f32x16& p, int s8) {
    v4u w; w.x = cvtpk(p[s8 + 0], p[s8 + 1]); w.y = cvtpk(p[s8 + 2], p[s8 + 3]); w.z = cvtpk(p[s8 + 4], p[s8 + 5]); w.w = cvtpk(p[s8 + 6], p[s8 + 7]);
    return __builtin_bit_cast(bf16x8, w);
}
__device__ __forceinline__ float max16(const f32x16& p) {
    const float a = fmaxf(fmaxf(p[0], p[1]), p[2]), b = fmaxf(fmaxf(p[3], p[4]), p[5]), c = fmaxf(fmaxf(p[6], p[7]), p[8]), d = fmaxf(fmaxf(p[9], p[10]), p[11]);
    const float e = fmaxf(fmaxf(p[12], p[13]), p[14]);
    return fmaxf(fmaxf(fmaxf(a, b), c), fmaxf(fmaxf(d, e), p[15]));
}
__device__ __forceinline__ void glds16(const void* gsrc, unsigned lds_dst) { unsigned keep;
    asm volatile("s_mov_b32 %0, m0\n\ts_mov_b32 m0, %2\n\ts_nop 0\n\tglobal_load_lds_dwordx4 %1, off\n\ts_mov_b32 m0, %0" : "=&s"(keep) : "v"(gsrc), "s"(lds_dst) : "memory"); }
#define ATT_WAIT_BAR(N) asm volatile("s_waitcnt vmcnt(" #N ") lgkmcnt(0)\n\ts_barrier" ::: "memory")

template <bool FULL> __device__ __forceinline__ void qk_tile(f32x16 (&p)[2], const LAS unsigned char* kb, const bf16x8 (&qr)[4], const f32x16& cinit) {
#pragma unroll
    for (int d0 = 0; d0 < 4; ++d0) { const bf16x8 k0 = *(const LAS bf16x8*)(kb + d0 * 2048);
        p[0] = __builtin_amdgcn_mfma_f32_32x32x16_bf16(k0, qr[d0], d0 == 0 ? cinit : p[0], 0, 0, 0);
        if (FULL) { const bf16x8 k1 = *(const LAS bf16x8*)(kb + d0 * 2048 + 512); p[1] = __builtin_amdgcn_mfma_f32_32x32x16_bf16(k1, qr[d0], d0 == 0 ? cinit : p[1], 0, 0, 0); } }
}
template <bool FULL> __device__ __forceinline__ void pv_tile(f32x16 (&o)[2], const f32x16 (&p)[2], const LAS unsigned char* vb) {
    const bf16x8 pa0 = packp(p[0], 0), pa1 = packp(p[0], 8);
    bf16x8 pa2 = pa0, pa3 = pa1; if (FULL) { pa2 = packp(p[1], 0); pa3 = packp(p[1], 8); }
#pragma unroll
    for (int d0 = 0; d0 < 2; ++d0) {
#pragma unroll
        for (int ks = 0; ks < (FULL ? 4 : 2); ++ks) { const s16x4 lo = vtr(vb + d0 * 4096 + ks * 1024), h4 = vtr(vb + d0 * 4096 + ks * 1024 + 512);
            const bf16x8 vf = (bf16x8){lo[0], lo[1], lo[2], lo[3], h4[0], h4[1], h4[2], h4[3]};
            o[d0] = __builtin_amdgcn_mfma_f32_32x32x16_bf16(ks == 0 ? pa0 : (ks == 1 ? pa1 : (ks == 2 ? pa2 : pa3)), vf, o[d0], 0, 0, 0); } }
}
struct Lane { float mh, l; int r32, hi; LAS float* wsf; bool na; int kc0, qs; };
template <int NP, bool FIRST, int NPEND> __device__ __forceinline__ void softmax_tile(f32x16 (&p)[2], f32x16 (&pend)[2], Lane& L, f32x16& negm, f32x16& cloc, f32x16 (&o)[2]) {
    float rm = max16(p[0]); if (NP == 2) rm = fmaxf(rm, max16(p[1]));
    rm = swapmax(rm);
    if (FIRST || __any(rm > THR)) {
        const float dl = FIRST ? rm : fmaxf(rm, 0.f);
        L.mh += dl;
#pragma unroll
        for (int r = 0; r < 16; ++r) { p[0][r] -= dl; if (NP == 2) p[1][r] -= dl; if (NPEND >= 1) pend[0][r] -= dl; if (NPEND == 2) pend[1][r] -= dl; }
        const float nm = -L.mh;
#pragma unroll
        for (int r = 0; r < 16; ++r) negm[r] = nm;
        if (L.na) {
#pragma unroll
            for (int r = 0; r < 16; ++r) { const int kc = L.kc0 + (r & 3) + 8 * (r >> 2); cloc[r] = (kc >= L.qs && kc < L.qs + 16) ? nm : NEG; } }
        if (!FIRST) { const float f = __builtin_amdgcn_exp2f(-dl); L.l *= f; if (L.hi == 0) L.wsf[L.r32] = f;
#pragma unroll
            for (int r = 0; r < 16; ++r) { const float al = L.wsf[crow(r, L.hi)]; o[0][r] *= al; o[1][r] *= al; } }
    }
    float s = 0.f;
#pragma unroll
    for (int r = 0; r < 16; ++r) { p[0][r] = __builtin_amdgcn_exp2f(p[0][r]); s += p[0][r]; }
    if (NP == 2) {
#pragma unroll
        for (int r = 0; r < 16; ++r) { p[1][r] = __builtin_amdgcn_exp2f(p[1][r]); s += p[1][r]; } }
    L.l += s;
}

__device__ __forceinline__ void attn_unit(Frame& F, const Params& P, int u) {
    const int tid = opaque(F.tid), lane = tid & 63, wid = F.wave, r32 = lane & 31, hi = lane >> 5;
    LAS unsigned char* lds = F.lds;
    const unsigned lds0 = (unsigned)(uintptr_t)lds;
    LAS float* tbl = (LAS float*)(lds + TBL_OFF);
    const bool is_na = u < 512;
    int b, h, ntiles, nfull, rlo = 0, r0 = 0;
    if (is_na) { b = u >> 7; h = (u >> 3) & 15; r0 = 4 * (u & 7); rlo = r0 - 4; rlo = rlo < 0 ? 0 : rlo; int rh = r0 - 1; rh = rh < 0 ? 0 : (rh > 24 ? 24 : rh); ntiles = 8 + (rh + 7 - rlo + 1); nfull = 8; }
    else { const int uu = u - 512; b = uu >> 4; h = uu & 15; ntiles = 4; nfull = 4; }
    int tq, rq = 0, cq = 0, bs = 0, ra = 0;
    if (is_na) { const int jb = wid >> 1; ra = r0 + 2 * (wid & 1); rq = ra + (r32 >> 4); cq = 16 * jb + (r32 & 15); tq = NCTX + b * LSEQ + rq * GWID + cq; bs = jb == 0 ? 0 : (jb == 1 ? 8 : (jb == 2 ? 24 : 32)); }
    else tq = b * SEQ + wid * 32 + r32;
    int rsq = rq - 4; rsq = rsq < 0 ? 0 : (rsq > 24 ? 24 : rsq);
    int qs = cq - 8; qs = qs < 0 ? 0 : (qs > 48 ? 48 : qs);
    int alo = ra - 4; alo = alo < 0 ? 0 : (alo > 24 ? 24 : alo); int ahi = ra - 3; ahi = ahi < 0 ? 0 : (ahi > 24 ? 24 : ahi); ahi += 8;
    const size_t koff = (size_t)lane * D + h * DH + wid * 8;
    const size_t voff = (size_t)(16 * (wid & 3) + (lane >> 2)) * D + h * DH + (wid >> 2) * 32 + (lane & 3) * 8;
    const unsigned kdst = lds0 + KOFF + wid * 1024, vdst = lds0 + VOFF + wid * 1024;
#define ATT_DMA(t) do { const bf16 *kp_, *vp_; \
        if (is_na && (t) < 8) { const size_t o_ = ((size_t)(b * 2 + P.j) * PAST + 64 * (t)) * D; kp_ = P.CK + o_; vp_ = P.CV + o_; } \
        else { const size_t o_ = (is_na ? (size_t)(NCTX + b * LSEQ + (rlo + (t) - 8) * GWID) : (size_t)(b * SEQ + 64 * (t))) * D; kp_ = P.K + o_; vp_ = P.V + o_; } \
        const unsigned so_ = (unsigned)((t) & (NSLOT - 1)) * SLOT; \
        glds16(kp_ + koff, (unsigned)__builtin_amdgcn_readfirstlane(kdst + so_)); glds16(vp_ + voff, (unsigned)__builtin_amdgcn_readfirstlane(vdst + so_)); } while (0)
    if (is_na) { for (int i = tid; i < 16 * TBL_STRIDE; i += NTHR) { const int row = i / TBL_STRIDE, x = i % TBL_STRIDE; float v = 0.f;
            if (row == 15) v = NEG; else if (x >= 16 && x < 47) v = P.rpb[((size_t)P.j * NH + h) * 465 + row * 31 + (x - 16)] * LOG2E_F;
            tbl[i] = v; } }
    bf16x8 qr[4];
#pragma unroll
    for (int d0 = 0; d0 < 4; ++d0) qr[d0] = *(const bf16x8*)(P.Q + (size_t)tq * D + h * DH + d0 * 16 + hi * 8);
    ATT_DMA(0); ATT_DMA(1); ATT_DMA(2);
    Lane L; L.mh = 0.f; L.l = 0.f; L.r32 = r32; L.hi = hi; L.wsf = (LAS float*)(lds + WSF_OFF) + wid * 32; L.na = is_na; L.kc0 = bs + 4 * hi; L.qs = qs;
    f32x16 o[2], negm, cloc;
#pragma unroll
    for (int r = 0; r < 16; ++r) { o[0][r] = 0.f; o[1][r] = 0.f; negm[r] = 0.f; cloc[r] = 0.f; }
    const unsigned vrd = VOFF + ((lane >> 4) & 1) * 32 + (lane & 3) * 8 + (4 * hi + ((lane & 15) >> 2)) * 64;
    const unsigned kfull = hi * 1024 + r32 * 16, kloc = hi * 1024 + (bs + r32) * 16, vloc = vrd + (bs >> 3) * 512;
    const int tb0 = 16 + bs - cq + 15 + 4 * hi;
    const bool late = ATT_PINGPONG && wid >= 4;
    f32x16 sa[2], sb[2];
#define ATT_SLOT(t) (lds + ((t) & (NSLOT - 1)) * SLOT)
#define ATT_SEAM(t) do { if ((t) + 3 <= ntiles) ATT_WAIT_BAR(2); else ATT_WAIT_BAR(0); if ((t) + 3 < ntiles) ATT_DMA((t) + 3); } while (0)
#define ATT_ALIVE(t) ((rlo + (t) - 8) >= alo && (rlo + (t) - 8) < ahi)
#define ATT_BIAS(S, t) do { const int rr_ = rlo + (t) - 8; const int rsel_ = (rr_ >= rsq && rr_ < rsq + 8) ? rr_ - rq + 7 : 15; const LAS float* tp_ = tbl + rsel_ * TBL_STRIDE + tb0; \
        _Pragma("unroll") for (int r = 0; r < 16; ++r) S[0][r] += tp_[(r & 3) + 8 * (r >> 2)]; } while (0)
#define ATT_P1 __builtin_amdgcn_s_setprio(1)
#define ATT_P0 __builtin_amdgcn_s_setprio(0)
#define ITER_FF(CUR, NXT, t, FIRST) do { ATT_SEAM(t); \
        if (!late) { ATT_P1; qk_tile<true>(NXT, ATT_SLOT((t) + 1) + kfull, qr, negm); ATT_P0; softmax_tile<2, FIRST, 2>(CUR, NXT, L, negm, cloc, o); ATT_P1; pv_tile<true>(o, CUR, ATT_SLOT(t) + vrd); ATT_P0; } \
        else { softmax_tile<2, FIRST, 0>(CUR, NXT, L, negm, cloc, o); ATT_P1; pv_tile<true>(o, CUR, ATT_SLOT(t) + vrd); qk_tile<true>(NXT, ATT_SLOT((t) + 1) + kfull, qr, negm); ATT_P0; } } while (0)
#define ITER_FL(CUR, NXT, t) do { ATT_SEAM(t); const bool an_ = ATT_ALIVE((t) + 1); \
        if (!late) { if (an_) { ATT_P1; qk_tile<false>(NXT, ATT_SLOT((t) + 1) + kloc, qr, cloc); ATT_P0; } softmax_tile<2, false, 1>(CUR, NXT, L, negm, cloc, o); ATT_P1; pv_tile<true>(o, CUR, ATT_SLOT(t) + vrd); ATT_P0; } \
        else { softmax_tile<2, false, 0>(CUR, NXT, L, negm, cloc, o); ATT_P1; pv_tile<true>(o, CUR, ATT_SLOT(t) + vrd); if (an_) qk_tile<false>(NXT, ATT_SLOT((t) + 1) + kloc, qr, cloc); ATT_P0; } } while (0)
#define ITER_LL(CUR, NXT, t) do { ATT_SEAM(t); const bool ac_ = ATT_ALIVE(t), an_ = ATT_ALIVE((t) + 1); \
        if (!late) { if (an_) { ATT_P1; qk_tile<false>(NXT, ATT_SLOT((t) + 1) + kloc, qr, cloc); ATT_P0; } \
            if (ac_) { ATT_BIAS(CUR, t); softmax_tile<1, false, 1>(CUR, NXT, L, negm, cloc, o); ATT_P1; pv_tile<false>(o, CUR, ATT_SLOT(t) + vloc); ATT_P0; } } \
        else { if (ac_) { ATT_BIAS(CUR, t); softmax_tile<1, false, 0>(CUR, NXT, L, negm, cloc, o); ATT_P1; pv_tile<false>(o, CUR, ATT_SLOT(t) + vloc); ATT_P0; } \
            if (an_) { ATT_P1; qk_tile<false>(NXT, ATT_SLOT((t) + 1) + kloc, qr, cloc); ATT_P0; } } } while (0)
#define LAST_L(CUR, t) do { if (ATT_ALIVE(t)) { ATT_BIAS(CUR, t); softmax_tile<1, false, 0>(CUR, CUR, L, negm, cloc, o); pv_tile<false>(o, CUR, ATT_SLOT(t) + vloc); } } while (0)
    ATT_WAIT_BAR(4);
    qk_tile<true>(sa, lds + kfull, qr, negm);
    int t = 0;
    ITER_FF(sa, sb, 0, true); t = 1;
    for (; t + 2 < nfull; t += 2) { ITER_FF(sb, sa, t, false); ITER_FF(sa, sb, t + 1, false); }
    if (is_na) {
        ITER_FL(sb, sa, t); ++t;
        for (; t + 2 < ntiles; t += 2) { ITER_LL(sa, sb, t); ITER_LL(sb, sa, t + 1); }
        if (t + 1 < ntiles) { ITER_LL(sa, sb, t); ++t; LAST_L(sb, t); } else LAST_L(sa, t);
    } else { softmax_tile<2, false, 0>(sb, sb, L, negm, cloc, o); pv_tile<true>(o, sb, ATT_SLOT(t) + vrd); }
#undef ATT_DMA
#undef ATT_SLOT
#undef ATT_SEAM
#undef ATT_ALIVE
#undef ATT_BIAS
#undef ATT_P1
#undef ATT_P0
#undef ITER_FF
#undef ITER_FL
#undef ITER_LL
#undef LAST_L
    float lt = swapadd(L.l);
    if (hi == 0) L.wsf[r32] = __builtin_amdgcn_rcpf(lt);
    ATT_WAIT_BAR(0);
    LAS unsigned char* stg = lds + wid * (32 * STG_ROW);
    float rl[16];
#pragma unroll
    for (int r = 0; r < 16; ++r) rl[r] = L.wsf[crow(r, hi)];
    asm volatile("s_waitcnt lgkmcnt(0)" ::: "memory");
#pragma unroll
    for (int r = 0; r < 16; ++r) { const int qi = crow(r, hi);
        *(LAS float*)(stg + qi * STG_ROW + r32 * 4) = o[0][r] * rl[r]; *(LAS float*)(stg + qi * STG_ROW + 128 + r32 * 4) = o[1][r] * rl[r]; }
#pragma unroll
    for (int i = 0; i < 4; ++i) { const int qi = i * 8 + (lane >> 3), ch = lane & 7;
        int tok; if (is_na) tok = NCTX + b * LSEQ + (ra + (qi >> 4)) * GWID + 16 * (wid >> 1) + (qi & 15); else tok = b * SEQ + wid * 32 + qi;
        const f32x4 x0 = *(const LAS f32x4*)(stg + qi * STG_ROW + ch * 32), x1 = *(const LAS f32x4*)(stg + qi * STG_ROW + ch * 32 + 16);
        const size_t idx = (size_t)tok * D + h * DH + ch * 8;
        const v4u z = *(const v4u*)(P.SZ + idx);
        v4u w; w.x = cvtpk(x0[0] * bflo(z.x), x0[1] * bfhi(z.x)); w.y = cvtpk(x0[2] * bflo(z.y), x0[3] * bfhi(z.y)); w.z = cvtpk(x1[0] * bflo(z.z), x1[1] * bfhi(z.z)); w.w = cvtpk(x1[2] * bflo(z.w), x1[3] * bfhi(z.w));
        *(v4u*)(P.G + idx) = w; }
    ATT_WAIT_BAR(0);
}
}
__device__ __forceinline__ void phase_attn(Frame& F, const Args& a, int j) {
    att::Params P{(const bf16*)(a.ws + WS_B0), (const bf16*)(a.ws + WS_B2), (const bf16*)(a.ws + WS_B3), (const bf16*)(a.ws + WS_B1), (const bf16*)(a.ws + WS_CKB), (const bf16*)(a.ws + WS_CVB),
                  (bf16*)(a.ws + WS_G), a.in[16], j};
    for (int u = F.vcu; u < 768; u += F.G) att::attn_unit(F, P, u);
}

__device__ __forceinline__ void phase_final(Frame& F, const Args& a) {
    const float* ssp = (const float*)(a.ws + WS_SSP); const float* fg = a.in[18];
    const int gw = F.vcu * NWAVES + F.wave, NGW = F.G * NWAVES;
    for (int t = gw; t < NTOK; t += NGW) {
        const float rs = pg8::row_rscale(ssp, t);
        float* xr = a.out + (size_t)t * D;
#pragma unroll
        for (int jj = 0; jj < 4; ++jj) { const int k = jj * 256 + F.lane * 4; f32x4 v = *(const f32x4*)(xr + k); const f32x4 g4 = *(const f32x4*)(fg + k);
            *(f32x4*)(xr + k) = v * rs * g4; }
    }
}

#ifndef MK_ONE_LAUNCH
#define MK_ONE_LAUNCH 1
#endif
#ifndef REP_PHASE
#define REP_PHASE (-1)
#define REP_COUNT 1
#endif
#define NREP(k) ((k) == REP_PHASE ? REP_COUNT : 1)
constexpr int N_PHASES = 15, M192_TILES = NTOK / 192;
__global__ void __launch_bounds__(NTHR, 2) mk_fwd(Args args) {
    extern __shared__ __attribute__((aligned(16))) unsigned char lds[];
    Frame F;
    F.lds = (LAS unsigned char*)lds;
    F.MISC = (volatile LAS unsigned*)(F.lds + MISC_OFF);
    F.tid = threadIdx.x; asm volatile("" : "+v"(F.tid)); F.lane = F.tid & 63; F.wave = __builtin_amdgcn_readfirstlane(F.tid >> 6);
    F.G = gridDim.x; { const int bx = blockIdx.x; F.vcu = (F.G % 8 == 0) ? (bx % 8) * (F.G / 8) + bx / 8 : bx; }
    unsigned char* ws = args.ws;
    F.ctl = (gu32*)(ws + WS_CTL);
    const int lo = args.ph_lo, hi = args.ph_hi;
#define IN(k) (lo <= (k) && (k) < hi)
    for (int u = F.tid; u < (LDS_BYTES - LDSCTL_OFF) / 4; u += NTHR) ((LAS unsigned*)(F.lds + LDSCTL_OFF))[u] = 0u;
    __syncthreads();
    XcdBarrier bar = xcd_barrier_post((unsigned*)(F.ctl + CW_BAR), F.MISC + 8);
#define BOTH(k) (IN(k) && IN((k) + 1))
#define SEAM(k) do { if (BOTH(k)) xcd_barrier(bar); } while (0)
    if (IN(0)) { for (int rep = 0; rep < NREP(0); ++rep) { phase_p0a(F, args); SEAM(0); } }
    if (IN(1)) { for (int rep = 0; rep < NREP(1); ++rep) { phase_p0b(F, args); SEAM(1); } }
    bf16* XS = (bf16*)(ws + WS_XS); bf16* G = (bf16*)(ws + WS_G); bf16* B0 = (bf16*)(ws + WS_B0); bf16* B1 = (bf16*)(ws + WS_B1); bf16* B2 = (bf16*)(ws + WS_B2); bf16* B3 = (bf16*)(ws + WS_B3);
    float* ssp = (float*)(ws + WS_SSP); const float* mod = (const float*)(ws + WS_MOD);
    float* x = args.out; float* newk = args.out + (size_t)NTOK * D; float* newv = newk + (size_t)NCTX_B * 2 * SEQ * D;
#pragma unroll 1
    for (int layer = 0; layer < DEPTH; ++layer) {
        const int j = layer >> 1;
        const float* bias = (const float*)(ws + WS_BIAS) + (size_t)layer * NMG * 4096;
        if (IN(2 + 3 * layer)) {
          for (int rep = 0; rep < NREP(2 + 3 * layer); ++rep) {
            if ((layer & 1) == 0) {
                pg8::Gemm g{XS, (const bf16*)(ws + WS_WCI) + (size_t)j * 3072 * D, NTOK, 3072, D}; pg8::StaticOrder S; S.init(M192_TILES * 256, 3072, F.G, (int)blockIdx.x);
                pg8::EpiConv1<true> E{ssp, bias, B0, B1};
                pg8::gemm_phase<pg8::EpiConv1<true>, pg8::StaticOrder, true, true, true>(F.lds + RING_OFF, g, S, E);
            } else {
                pg8::Gemm g{XS, (const bf16*)(ws + WS_WNI) + (size_t)j * 4096 * D, NTOK, 4096, D}; pg8::StaticOrder S; S.init(NTOK, 4096, F.G, (int)blockIdx.x);
                pg8::EpiAttn1 E{ssp, bias, B0, (size_t)(WS_B1 - WS_B0) / 2, newk, (size_t)NCTX_B * 2 * SEQ * D, j};
                pg8::gemm_phase<pg8::EpiAttn1, pg8::StaticOrder, true, true>(F.lds + RING_OFF, g, S, E);
            }
            SEAM(2 + 3 * layer);
          }
        }
        if (IN(3 + 3 * layer)) {
          for (int rep = 0; rep < NREP(3 + 3 * layer); ++rep) {
#ifndef NO_CONV
            if ((layer & 1) == 0) phase_conv(F, args, j);
#endif
#ifndef NO_ATTN
            if ((layer & 1) == 1) phase_attn(F, args, j);
#endif
            SEAM(3 + 3 * layer);
          }
        }
        if (IN(4 + 3 * layer)) {
          for (int rep = 0; rep < NREP(4 + 3 * layer); ++rep) {
            const bf16* WT = (layer & 1) ? (const bf16*)(ws + WS_WNO) + (size_t)j * D * D : (const bf16*)(ws + WS_WCO) + (size_t)j * D * D;
            pg8::Gemm g{G, WT, NTOK, D, D}; pg8::StaticOrder S; S.init(M192_TILES * 256, D, F.G, (int)blockIdx.x);
            const float* bc = layer == 0 ? args.in[0] : x; const float* bl = layer == 0 ? args.in[1] : x + (size_t)NCTX * D;
            const float* gate = mod + (size_t)layer * 3 * D + 2 * D;
            if (layer < DEPTH - 1) {
                pg8::EpiGemm2<true, true> E{bc, bl, x, gate, DEPTH * 3 * D, (const float*)(ws + WS_GS) + (size_t)(layer + 1) * NMG * D, XS, ssp};
                pg8::gemm_phase<pg8::EpiGemm2<true, true>, pg8::StaticOrder, true, true, true>(F.lds + RING_OFF, g, S, E);
            } else {
                pg8::EpiGemm2<false, true> E{bc, bl, x, gate, DEPTH * 3 * D, nullptr, XS, ssp};
                pg8::gemm_phase<pg8::EpiGemm2<false, true>, pg8::StaticOrder, true, true, true>(F.lds + RING_OFF, g, S, E);
            }
            SEAM(4 + 3 * layer);
          }
        }
    }
    if (IN(14)) phase_final(F, args);
#undef IN
#undef BOTH
#undef SEAM
}

__global__ void __launch_bounds__(256) k_conv_b(const bf16* __restrict__ U, const bf16* __restrict__ SZ, const float* __restrict__ dw_w, const float* __restrict__ dw_b,
                                                 const float* __restrict__ ln_g, const float* __restrict__ ln_b, bf16* __restrict__ Gb) {
    const int t = blockIdx.x;
    int s0, len;
    if (t < NCTX) { s0 = (t / SEQ) * SEQ; len = SEQ; } else { s0 = NCTX + ((t - NCTX) / LSEQ) * LSEQ; len = LSEQ; }
    const int l = t - s0;
    float v[4]; float s = 0.f;
#pragma unroll
    for (int i = 0; i < 4; ++i) {
        int c = threadIdx.x + i * 256;
        float acc = dw_b[c];
        for (int k = 0; k < CK; ++k) { int ll = l + k - CK / 2; if (ll >= 0 && ll < len) acc += bf2f(U[(size_t)(s0 + ll) * D + c]) * dw_w[k * D + c]; }
        v[i] = acc; s += acc;
    }
    __shared__ float red[256];
    red[threadIdx.x] = s; __syncthreads();
    for (int o = 128; o > 0; o >>= 1) { if (threadIdx.x < o) red[threadIdx.x] += red[threadIdx.x + o]; __syncthreads(); }
    const float mu = red[0] / D; __syncthreads();
    float q = 0.f;
#pragma unroll
    for (int i = 0; i < 4; ++i) { float d = v[i] - mu; q += d * d; }
    red[threadIdx.x] = q; __syncthreads();
    for (int o = 128; o > 0; o >>= 1) { if (threadIdx.x < o) red[threadIdx.x] += red[threadIdx.x + o]; __syncthreads(); }
    const float rstd = rsqrtf(red[0] / D + EPS);
#pragma unroll
    for (int i = 0; i < 4; ++i) { int c = threadIdx.x + i * 256; float u = (v[i] - mu) * rstd * ln_g[c] + ln_b[c];
        Gb[(size_t)t * D + c] = (bf16)f2bf(silu_f(u) * bf2f(SZ[(size_t)t * D + c])); }
}

__global__ void __launch_bounds__(256) k_ctx_attn_b(const bf16* __restrict__ Q, const bf16* __restrict__ K, const bf16* __restrict__ V, const bf16* __restrict__ SZ, bf16* __restrict__ Gb) {
    const int t = blockIdx.x, h = blockIdx.y, b = t / SEQ;
    __shared__ float sq[DH]; __shared__ float sp[SEQ]; __shared__ float red[256];
    if (threadIdx.x < DH) sq[threadIdx.x] = bf2f(Q[(size_t)t * D + h * DH + threadIdx.x]);
    __syncthreads();
    const int l = threadIdx.x;
    const bf16* kr = K + (size_t)(b * SEQ + l) * D + h * DH;
    float sc = 0.f;
    for (int d = 0; d < DH; ++d) sc += sq[d] * bf2f(kr[d]);
    red[threadIdx.x] = sc; __syncthreads();
    for (int o = 128; o > 0; o >>= 1) { if (threadIdx.x < o) red[threadIdx.x] = fmaxf(red[threadIdx.x], red[threadIdx.x + o]); __syncthreads(); }
    const float mx = red[0]; __syncthreads();
    const float p = exp2f(sc - mx);
    sp[l] = p; red[threadIdx.x] = p; __syncthreads();
    for (int o = 128; o > 0; o >>= 1) { if (threadIdx.x < o) red[threadIdx.x] += red[threadIdx.x + o]; __syncthreads(); }
    const float inv = 1.f / red[0];
    if (threadIdx.x < DH) { const int d = threadIdx.x; float o = 0.f;
        for (int ll = 0; ll < SEQ; ++ll) o += sp[ll] * bf2f(V[(size_t)(b * SEQ + ll) * D + h * DH + d]);
        const size_t idx = (size_t)t * D + h * DH + d;
        Gb[idx] = (bf16)f2bf(o * inv * bf2f(SZ[idx])); }
}

__global__ void __launch_bounds__(256) k_na_attn_b(const bf16* __restrict__ Q, const bf16* __restrict__ K, const bf16* __restrict__ V, const bf16* __restrict__ SZ,
                                                    const bf16* __restrict__ CKb, const bf16* __restrict__ CVb, const float* __restrict__ rpb, int j, bf16* __restrict__ Gb) {
    const int tl = blockIdx.x, h = blockIdx.y;
    const int b = tl / LSEQ, n = tl % LSEQ, r = n / GWID, c = n % GWID;
    const int t = NCTX + tl;
    __shared__ float sq[DH]; __shared__ float sp[128 + PAST]; __shared__ float red[256];
    if (threadIdx.x < DH) sq[threadIdx.x] = bf2f(Q[(size_t)t * D + h * DH + threadIdx.x]);
    __syncthreads();
    int rs = r - 4; rs = rs < 0 ? 0 : (rs > 24 ? 24 : rs);
    int qs = c - 8; qs = qs < 0 ? 0 : (qs > 48 ? 48 : qs);
    const bf16* ck = CKb + ((size_t)(b * 2 + j) * PAST) * D + h * DH;
    const bf16* cv = CVb + ((size_t)(b * 2 + j) * PAST) * D + h * DH;
    const float* rp = rpb + ((size_t)j * NH + h) * 15 * 31;
    float mx = -3.0e38f;
    for (int i = threadIdx.x; i < 128 + PAST; i += 256) {
        float sc = 0.f;
        if (i < 128) { int rr = rs + i / 16, kc = qs + i % 16;
            const bf16* kr = K + (size_t)(NCTX + b * LSEQ + rr * GWID + kc) * D + h * DH;
            for (int d = 0; d < DH; ++d) sc += sq[d] * bf2f(kr[d]);
            int dr = rr - r + 7, dc = kc - c + 15; dc = dc < 0 ? 0 : (dc > 30 ? 30 : dc);
            sc += rp[dr * 31 + dc] * LOG2E_F;
        } else { const bf16* kr = ck + (size_t)(i - 128) * D; for (int d = 0; d < DH; ++d) sc += sq[d] * bf2f(kr[d]); }
        sp[i] = sc; mx = fmaxf(mx, sc);
    }
    red[threadIdx.x] = mx; __syncthreads();
    for (int o = 128; o > 0; o >>= 1) { if (threadIdx.x < o) red[threadIdx.x] = fmaxf(red[threadIdx.x], red[threadIdx.x + o]); __syncthreads(); }
    mx = red[0]; __syncthreads();
    float ps = 0.f;
    for (int i = threadIdx.x; i < 128 + PAST; i += 256) { float p = exp2f(sp[i] - mx); sp[i] = p; ps += p; }
    red[threadIdx.x] = ps; __syncthreads();
    for (int o = 128; o > 0; o >>= 1) { if (threadIdx.x < o) red[threadIdx.x] += red[threadIdx.x + o]; __syncthreads(); }
    const float inv = 1.f / red[0];
    if (threadIdx.x < DH) { const int d = threadIdx.x; float o = 0.f;
        for (int i = 0; i < 128; ++i) { int rr = rs + i / 16, kc = qs + i % 16; o += sp[i] * bf2f(V[(size_t)(NCTX + b * LSEQ + rr * GWID + kc) * D + h * DH + d]); }
        for (int i = 0; i < PAST; ++i) o += sp[128 + i] * bf2f(cv[(size_t)i * D + d]);
        const size_t idx = (size_t)t * D + h * DH + d;
        Gb[idx] = (bf16)f2bf(o * inv * bf2f(SZ[idx])); }
}

extern "C" void kernel_launch(void* const* d_in, const int* in_sizes, int n_in, void* d_out, int out_size, void* d_ws, size_t ws_size, hipStream_t stream) {
    static int grid = 0;
    if (grid == 0) {
        int dev = 0, cus = 0, per_cu = 0;
        if (n_in != 19 || ws_size < WS_END) { fprintf(stderr, "kernel_launch: unexpected n_in %d / ws %zu\n", n_in, ws_size); grid = -1; return; }
        if (hipGetDevice(&dev) != hipSuccess || hipDeviceGetAttribute(&cus, hipDeviceAttributeMultiprocessorCount, dev) != hipSuccess) { grid = -1; return; }
        if (hipFuncSetAttribute((const void*)mk_fwd, hipFuncAttributeMaxDynamicSharedMemorySize, LDS_BYTES) != hipSuccess) { fprintf(stderr, "kernel_launch: hipFuncSetAttribute failed\n"); grid = -1; return; }
        if (hipOccupancyMaxActiveBlocksPerMultiprocessor(&per_cu, (const void*)mk_fwd, NTHR, LDS_BYTES) != hipSuccess || per_cu < 1) { fprintf(stderr, "kernel_launch: occupancy query says %d\n", per_cu); }
        (void)hipGetLastError();
        grid = cus;
    }
    if (grid < 0) return;
    (void)hipMemsetAsync((char*)d_ws + WS_CTL, 0, CTL_ZERO_BYTES, stream);
    Args a{};
    for (int i = 0; i < 19; ++i) a.in[i] = (const float*)d_in[i];
    a.out = (float*)d_out; a.ws = (unsigned char*)d_ws;
    unsigned char* ws = (unsigned char*)d_ws;
    bf16* G = (bf16*)(ws + WS_G); bf16* B0 = (bf16*)(ws + WS_B0); bf16* B1 = (bf16*)(ws + WS_B1); bf16* B2 = (bf16*)(ws + WS_B2); bf16* B3 = (bf16*)(ws + WS_B3);
    auto run = [&](int lo, int hi) { a.ph_lo = lo; a.ph_hi = hi; hipLaunchKernelGGL(mk_fwd, dim3(grid), dim3(NTHR), LDS_BYTES, stream, a); };
#if MK_ONE_LAUNCH
    run(0, N_PHASES);
#else
    for (int ph = 0; ph < N_PHASES; ++ph) run(ph, ph + 1);
#endif
    (void)G; (void)B0; (void)B1; (void)B2; (void)B3;
}
```
